# Optimizing an MI355X kernel written in HIP

```python
import math
import jax, jax.numpy as jnp
from jax import lax
import numpy as np

D_MODEL = 1024
BATCH = 8
SEQ = 4096
DEPTH = 1

MEM_LEN = 256
N_MLSTM_HEADS = 4
MLSTM_HEAD_DIM = 128
MLSTM_WIDTH = N_MLSTM_HEADS * MLSTM_HEAD_DIM
CONV_WIDTH = 4
MLSTM_CHUNK = 128
N_DIFF_HEADS = 4
DIFF_QK_DIM = 64
DIFF_V_DIM = 2 * DIFF_QK_DIM
DIFF_WIDTH = N_DIFF_HEADS * DIFF_V_DIM
Q_BLOCK = 128
N_MEM_HEADS = 4
MEM_HEAD_DIM = 128
MEM_WIDTH = N_MEM_HEADS * MEM_HEAD_DIM
MIX_WIDTH = MLSTM_WIDTH + DIFF_WIDTH + MEM_WIDTH
IN_WIDTHS = (MLSTM_WIDTH, MLSTM_WIDTH, MLSTM_WIDTH,
             2 * N_DIFF_HEADS * DIFF_QK_DIM, 2 * N_DIFF_HEADS * DIFF_QK_DIM, DIFF_WIDTH, DIFF_WIDTH,
             MEM_WIDTH, MEM_WIDTH)
IN_WIDTH = 4608
NORM_EPS = 1e-6

kernel_name = 'hybrid_mlstm_diffattn_memxattn'


def _split_cols(a, widths):
    offs = np.cumsum(widths)[:-1].tolist()
    return jnp.split(a, offs, axis=-1)


def rmsnorm(x, g):
    xf = x.astype(jnp.float32)
    y = xf * lax.rsqrt(jnp.mean(xf * xf, axis=-1, keepdims=True) + NORM_EPS)
    return (y * g.astype(jnp.float32)).astype(x.dtype)


def head_layernorm(h, g):
    mu = jnp.mean(h, axis=-1, keepdims=True)
    var = jnp.mean(jnp.square(h - mu), axis=-1, keepdims=True)
    y = (h - mu) * lax.rsqrt(var + NORM_EPS)
    y = y.reshape(h.shape[0], h.shape[1], -1)
    return y * g.astype(jnp.float32)


def causal_depthwise_conv(x, w, b):
    y = lax.conv_general_dilated(x, w[:, None, :], window_strides=(1,),
                                 padding=[(CONV_WIDTH - 1, 0)],
                                 dimension_numbers=('NWC', 'WIO', 'NWC'),
                                 feature_group_count=x.shape[-1])
    return y + b


def mlstm_chunkwise(q, k, v, i_pre, f_pre):
    B_, H_, S_, dh = q.shape
    L = MLSTM_CHUNK
    nc = S_ // L
    k = k * (dh ** -0.5)
    log_f = jax.nn.log_sigmoid(f_pre)

    def chunks(a):
        a = a.reshape((B_, H_, nc, L) + a.shape[3:])
        return jnp.moveaxis(a, 2, 0)

    qc, kc, vc, ic = chunks(q), chunks(k), chunks(v), chunks(i_pre)
    bc = jnp.cumsum(chunks(log_f), axis=-1)
    tri = jnp.tril(jnp.ones((L, L), dtype=bool))

    def step(carry, inp):
        C, n, m = carry
        qb, kb, vb, ib, bb = inp
        d = bb[..., :, None] - bb[..., None, :] + ib[..., None, :]
        d = jnp.where(tri, d, -jnp.inf)
        g = bb + m[..., None]
        m_t = jnp.maximum(g, jnp.max(d, axis=-1))
        s_qk = jnp.einsum('bhtk,bhsk->bhts', qb, kb) * jnp.exp(d - m_t[..., None])
        inter = jnp.exp(g - m_t)
        num = (jnp.einsum('bhts,bhsv->bhtv', s_qk, vb)
               + inter[..., None] * jnp.einsum('bhvk,bhtk->bhtv', C, qb))
        den = jnp.sum(s_qk, axis=-1) + inter * jnp.einsum('bhk,bhtk->bht', n, qb)
        h = num / jnp.maximum(jnp.abs(den), jnp.exp(-m_t))[..., None]
        b_end = bb[..., -1]
        a = b_end[..., None] - bb + ib
        m_new = jnp.maximum(b_end + m, jnp.max(a, axis=-1))
        wa = jnp.exp(a - m_new[..., None])
        decay = jnp.exp(b_end + m - m_new)
        C_new = decay[..., None, None] * C + jnp.einsum('bhs,bhsv,bhsk->bhvk', wa, vb, kb)
        n_new = decay[..., None] * n + jnp.einsum('bhs,bhsk->bhk', wa, kb)
        return (C_new, n_new, m_new), h

    init = (jnp.zeros((B_, H_, dh, dh), jnp.float32),
            jnp.zeros((B_, H_, dh), jnp.float32),
            jnp.zeros((B_, H_), jnp.float32))
    _, h = lax.scan(step, init, (qc, kc, vc, ic, bc))
    return jnp.moveaxis(h, 0, 2).reshape(B_, H_, S_, dh)


def diff_causal_attention(q, k, v, lam):
    S_ = q.shape[3]
    scale = DIFF_QK_DIM ** -0.5
    outs = []
    for j in range(S_ // Q_BLOCK):
        lo, hi = j * Q_BLOCK, (j + 1) * Q_BLOCK
        s = jnp.einsum('bhmqd,bhmkd->bhmqk', q[:, :, :, lo:hi], k[:, :, :, :hi]).astype(jnp.float32) * scale
        mask = jnp.arange(hi)[None, :] <= jnp.arange(lo, hi)[:, None]
        p = jax.nn.softmax(jnp.where(mask, s, -jnp.inf), axis=-1)
        pd = p[:, :, 0] - lam * p[:, :, 1]
        outs.append(jnp.einsum('bhqk,bhkd->bhqd', pd.astype(v.dtype), v[:, :, :hi]))
    return jnp.concatenate(outs, axis=2)


def setup_inputs(seed: int = 0) -> dict:
    key = jax.random.key(seed)
    ks = jax.random.split(key, 24)
    nrm = jax.random.normal
    f32 = jnp.float32
    H = N_MLSTM_HEADS
    b_i = 0.1 * nrm(ks[10], (DEPTH, H), f32)
    b_f = 3.0 + 3.0 * jax.random.uniform(ks[11], (DEPTH, H), f32)
    return {
        'x': nrm(ks[0], (BATCH, SEQ, D_MODEL), f32),
        'mem': nrm(ks[1], (BATCH, MEM_LEN, D_MODEL), f32),
        'norm_g': 1.0 + 0.02 * nrm(ks[2], (DEPTH, D_MODEL), f32),
        'w_in': nrm(ks[3], (DEPTH, D_MODEL, IN_WIDTH), f32) * D_MODEL ** -0.5,
        'conv_w': nrm(ks[4], (DEPTH, CONV_WIDTH, MLSTM_WIDTH), f32) * CONV_WIDTH ** -0.5,
        'conv_b': 0.01 * nrm(ks[5], (DEPTH, MLSTM_WIDTH), f32),
        'wq_m': nrm(ks[6], (DEPTH, H, MLSTM_HEAD_DIM, MLSTM_HEAD_DIM), f32) * MLSTM_HEAD_DIM ** -0.5,
        'wk_m': nrm(ks[7], (DEPTH, H, MLSTM_HEAD_DIM, MLSTM_HEAD_DIM), f32) * MLSTM_HEAD_DIM ** -0.5,
        'wv_m': nrm(ks[8], (DEPTH, H, MLSTM_HEAD_DIM, MLSTM_HEAD_DIM), f32) * MLSTM_HEAD_DIM ** -0.5,
        'w_if': nrm(ks[9], (DEPTH, 3 * MLSTM_WIDTH, 2 * H), f32) * (3 * MLSTM_WIDTH) ** -0.5,
        'b_if': jnp.concatenate([b_i, b_f], axis=-1),
        'mnorm_g': 1.0 + 0.02 * nrm(ks[12], (DEPTH, MLSTM_WIDTH), f32),
        'skip_m': 1.0 + 0.02 * nrm(ks[13], (DEPTH, MLSTM_WIDTH), f32),
        'lam_q1': 0.1 * nrm(ks[14], (DEPTH, DIFF_QK_DIM), f32),
        'lam_k1': 0.1 * nrm(ks[15], (DEPTH, DIFF_QK_DIM), f32),
        'lam_q2': 0.1 * nrm(ks[16], (DEPTH, DIFF_QK_DIM), f32),
        'lam_k2': 0.1 * nrm(ks[17], (DEPTH, DIFF_QK_DIM), f32),
        'dnorm_g': 1.0 + 0.02 * nrm(ks[18], (DEPTH, DIFF_WIDTH), f32),
        'mem_norm_g': 1.0 + 0.02 * nrm(ks[19], (DEPTH, D_MODEL), f32),
        'w_mem_kv': nrm(ks[20], (DEPTH, D_MODEL, 2 * MEM_WIDTH), f32) * D_MODEL ** -0.5,
        'w_out': nrm(ks[21], (DEPTH, MIX_WIDTH, D_MODEL), f32) * MIX_WIDTH ** -0.5,
        'final_g': 1.0 + 0.02 * nrm(ks[22], (D_MODEL,), f32),
    }


def reference(x, mem, norm_g, w_in, conv_w, conv_b, wq_m, wk_m, wv_m, w_if, b_if, mnorm_g, skip_m,
              lam_q1, lam_k1, lam_q2, lam_k2, dnorm_g, mem_norm_g, w_mem_kv, w_out, final_g):
    B_, S_, _ = x.shape
    Hm, dh = N_MLSTM_HEADS, MLSTM_HEAD_DIM
    Hd, Hc = N_DIFF_HEADS, N_MEM_HEADS
    for l in range(DEPTH):
        h = rmsnorm(x, norm_g[l])
        proj = h @ w_in[l]
        x_m, o_m, z_m, q_d, k_d, v_d, z_d, q_c, z_c = _split_cols(proj, IN_WIDTHS)

        x_cv = jax.nn.silu(causal_depthwise_conv(x_m, conv_w[l], conv_b[l]))
        xch = x_cv.reshape(B_, S_, Hm, dh)
        xmh = x_m.reshape(B_, S_, Hm, dh)
        q = jnp.einsum('bshd,hde->bshe', xch, wq_m[l])
        k = jnp.einsum('bshd,hde->bshe', xch, wk_m[l])
        v = jnp.einsum('bshd,hde->bshe', xmh, wv_m[l])
        qkv = jnp.concatenate([q, k, v], axis=2).reshape(B_, S_, 3 * MLSTM_WIDTH)
        gates = (qkv @ w_if[l] + b_if[l]).astype(jnp.float32)
        i_pre = jnp.transpose(gates[..., :Hm], (0, 2, 1))
        f_pre = jnp.transpose(gates[..., Hm:], (0, 2, 1))
        tr = lambda a: jnp.transpose(a.astype(jnp.float32), (0, 2, 1, 3))
        h_t = mlstm_chunkwise(tr(q), tr(k), tr(v), i_pre, f_pre)
        h_t = jnp.transpose(h_t, (0, 2, 1, 3))
        h_t = jax.nn.sigmoid(o_m.reshape(B_, S_, Hm, dh).astype(jnp.float32)) * h_t
        y_m = head_layernorm(h_t, mnorm_g[l]).astype(x.dtype)
        y_m = (y_m + skip_m[l] * x_cv) * jax.nn.silu(z_m)

        qd = jnp.transpose(q_d.reshape(B_, S_, Hd, 2, DIFF_QK_DIM), (0, 2, 3, 1, 4))
        kd = jnp.transpose(k_d.reshape(B_, S_, Hd, 2, DIFF_QK_DIM), (0, 2, 3, 1, 4))
        vd = jnp.transpose(v_d.reshape(B_, S_, Hd, DIFF_V_DIM), (0, 2, 1, 3))
        lam_init = 0.8 - 0.6 * math.exp(-0.3 * l)
        lam = (jnp.exp(jnp.sum(lam_q1[l].astype(jnp.float32) * lam_k1[l].astype(jnp.float32)))
               - jnp.exp(jnp.sum(lam_q2[l].astype(jnp.float32) * lam_k2[l].astype(jnp.float32)))
               + lam_init)
        od = jnp.transpose(diff_causal_attention(qd, kd, vd, lam), (0, 2, 1, 3))
        od = rmsnorm(od, dnorm_g[l].reshape(Hd, DIFF_V_DIM)) * (1.0 - lam_init)
        y_d = od.reshape(B_, S_, DIFF_WIDTH) * jax.nn.silu(z_d)

        kv = rmsnorm(mem, mem_norm_g[l]) @ w_mem_kv[l]
        km = kv[..., :MEM_WIDTH].reshape(B_, -1, Hc, MEM_HEAD_DIM)
        vm = kv[..., MEM_WIDTH:].reshape(B_, -1, Hc, MEM_HEAD_DIM)
        qc = q_c.reshape(B_, S_, Hc, MEM_HEAD_DIM)
        sc = jnp.einsum('bshd,bmhd->bhsm', qc, km).astype(jnp.float32) * MEM_HEAD_DIM ** -0.5
        pc = jax.nn.softmax(sc, axis=-1).astype(x.dtype)
        oc = jnp.einsum('bhsm,bmhd->bshd', pc, vm).reshape(B_, S_, MEM_WIDTH)
        y_c = oc * jax.nn.silu(z_c)

        y = jnp.concatenate([y_m, y_d, y_c], axis=-1) @ w_out[l]
        x = x + y
    return rmsnorm(x, final_g)
```

```cpp
#include <hip/hip_runtime.h>
#include <hip/hip_bf16.h>
#include <cstdio>
#include <cstdint>
#include <cmath>
namespace pg8 {
#define PG8_LAS __attribute__((address_space(3)))
typedef unsigned short bf16_t;
typedef short bf16x8 __attribute__((ext_vector_type(8)));
typedef float f32x4 __attribute__((ext_vector_type(4)));
typedef unsigned u32x4 __attribute__((ext_vector_type(4)));
constexpr int BM = 256, BK = 64, HALF = 128, HTB = HALF * BK * 2  , STAGE_BYTES = 8 * HTB, NXCD = 8, WGM = 8;

__host__ __device__ __forceinline__ int lds_byte(int r, int c) { const int st = (r >> 4) * 2 + (c >> 5), rr = r & 15, cc = c & 31, ob = rr * 64 + cc * 2; return st * 1024 + (ob ^ (((ob >> 9) & 1) << 5)); }
__host__ __device__ __forceinline__ void stage_rc(int b, int& R, int& C) { const int st = b / 1024, sb = b % 1024, swz = sb ^ (((sb >> 9) & 1) << 5); R = (st >> 1) * 16 + swz / 64; C = (st & 1) * 32 + (swz % 64) / 2; }
__host__ __device__ __forceinline__ int perm32(int rho) { const int n = rho >> 4, i = rho & 15; return 8 * (i >> 2) + 4 * n + (i & 3); }

struct Unit { int pm, pn; };
struct Gemm { const bf16_t* A; const bf16_t* Bt; int M, N, K; };

struct StaticOrder {
    int nM, nN, nwg, G, c;
    __host__ __device__ void init(int M, int N, int G_, int c_) { nM = M / BM; nN = N / BM; nwg = nM * nN; G = G_; c = c_; }
    __host__ __device__ bool next(int i, Unit& u) const {
        const long L = (long)i * G + c; if (L >= nwg) return false;
        int wgid = (int)L; { const int q = nwg / NXCD, r = nwg % NXCD, xcd = wgid % NXCD, off = wgid / NXCD; wgid = (xcd < r ? xcd * (q + 1) : r * (q + 1) + (xcd - r) * q) + off; }
        const int nig = WGM * nN, gid = wgid / nig, fm = gid * WGM, gsz = (nM - fm) < WGM ? (nM - fm) : WGM;
        u.pm = fm + ((wgid % nig) % gsz); u.pn = (wgid % nig) / gsz; return true;
    }
    __device__ __forceinline__ void a_ready(const Unit&) const {}
    __device__ __forceinline__ void done(const Unit&) const {}
};

__device__ __forceinline__ unsigned cvt_pk_bf16(float lo, float hi) { unsigned r; asm volatile("v_cvt_pk_bf16_f32 %0, %1, %2" : "=v"(r) : "v"(lo), "v"(hi)); return r; }
typedef float f32x2 __attribute__((ext_vector_type(2)));
__device__ __forceinline__ f32x2 gelu_pk(f32x2 v) {
    const f32x2 av = __builtin_elementwise_abs(v), d = av * 0.2316418882f + 1.0f;
    f32x2 t; t.x = __builtin_amdgcn_rcpf(d.x); t.y = __builtin_amdgcn_rcpf(d.y);
    f32x2 q = t * 0.5307027145f + (-0.7265760135f); q = q * t + 0.7107068705f; q = q * t + (-0.142248368f); q = q * t + 0.127414796f; q = q * t;
    const f32x2 s = (v * v) * (-0.72134752044f);
    f32x2 e; e.x = __builtin_amdgcn_exp2f(s.x); e.y = __builtin_amdgcn_exp2f(s.y);
    const f32x2 m = v * (q * e), r = v - m;
    f32x2 o; o.x = v.x < 0.f ? m.x : r.x; o.y = v.y < 0.f ? m.y : r.y; return o;
}

template <int ACT  > struct EpiBf16 {
    static constexpr bool PERM = true, AFTER_DRAIN = false; static_assert(ACT == 0 || ACT == 1, "EpiBf16: ACT is 0 (none) or 1 (gelu_pk)");
    bf16_t* O; int ldc; const float* bias; int split_cols; size_t split_stride; float scale0;
    __device__ __forceinline__ void operator()(const f32x4 (&acc)[2][2][4][2], const Unit& u, int wr, int wc, int fr, int fq) const {
        const int row0 = u.pm * BM + wr * 64 + fr; int colt = u.pn * BM; bf16_t* base = O;
        float sc = 1.f; if (split_cols) { const int t = colt / split_cols; base += (size_t)t * split_stride; colt -= t * split_cols; if (t == 0) sc = scale0; }
        const int col0 = colt + wc * 32 + 8 * fq, bcol0 = u.pn * BM + wc * 32 + 8 * fq;
        f32x4 bv[2][2];
#pragma unroll
        for (int bj = 0; bj < 2; ++bj)
#pragma unroll
            for (int n = 0; n < 2; ++n) bv[bj][n] = bias ? *(const f32x4*)(bias + bcol0 + bj * HALF + 4 * n) : (f32x4){0.f, 0.f, 0.f, 0.f};
#pragma unroll
        for (int ai = 0; ai < 2; ++ai)
#pragma unroll
            for (int m = 0; m < 4; ++m) { bf16_t* rowp = base + (size_t)(row0 + ai * HALF + m * 16) * ldc + col0;
#pragma unroll
                for (int bj = 0; bj < 2; ++bj) { f32x4 v0 = acc[ai][bj][m][0] + bv[bj][0], v1 = acc[ai][bj][m][1] + bv[bj][1];
                    if (ACT == 1) { f32x2 a = gelu_pk((f32x2){v0[0], v0[1]}), b = gelu_pk((f32x2){v0[2], v0[3]}), c = gelu_pk((f32x2){v1[0], v1[1]}), d = gelu_pk((f32x2){v1[2], v1[3]});
                        v0 = (f32x4){a.x, a.y, b.x, b.y}; v1 = (f32x4){c.x, c.y, d.x, d.y}; }
                    v0 = v0 * sc; v1 = v1 * sc; u32x4 w; w.x = cvt_pk_bf16(v0[0], v0[1]); w.y = cvt_pk_bf16(v0[2], v0[3]); w.z = cvt_pk_bf16(v1[0], v1[1]); w.w = cvt_pk_bf16(v1[2], v1[3]);
                    *(u32x4*)(rowp + bj * HALF) = w; } }
    }
};
struct EpiResSS {
    static constexpr bool PERM = false, AFTER_DRAIN = false;
    const float* base; float* out; int ldc; float* rowss;
    __device__ __forceinline__ void operator()(const f32x4 (&acc)[2][2][4][2], const Unit& u, int wr, int wc, int fr, int fq) const {
        const int row0 = u.pm * BM + wr * 64 + fr, col0 = u.pn * BM + wc * 32 + 4 * fq;
#pragma unroll
        for (int ai = 0; ai < 2; ++ai)
#pragma unroll
            for (int m = 0; m < 4; ++m) { const int row = row0 + ai * HALF + m * 16; const size_t off = (size_t)row * ldc + col0; float ss = 0.f;
#pragma unroll
                for (int bj = 0; bj < 2; ++bj)
#pragma unroll
                    for (int n = 0; n < 2; ++n) { const f32x4 b = *(const f32x4*)(base + off + bj * HALF + n * 16); const f32x4 v = acc[ai][bj][m][n] + b;
                        ss += (v[0] * v[0] + v[1] * v[1]) + (v[2] * v[2] + v[3] * v[3]); *(f32x4*)(out + off + bj * HALF + n * 16) = v; }
                ss += __shfl_xor(ss, 16); ss += __shfl_xor(ss, 32);
                if (fq == 0) atomicAdd(rowss + row, ss); }
    }
};
template <class Epi, class Sched, bool ALIGN_EPI = false, bool SP2 = false>
__device__ __forceinline__ void gemm_phase(PG8_LAS unsigned char* lds, const Gemm g, const Sched& S, const Epi& E) {
    const int tid = threadIdx.x, wid = __builtin_amdgcn_readfirstlane(tid >> 6), lane = tid & 63, wr = wid >> 2, wc = wid & 3, fr = lane & 15, fq = lane >> 4;
    const int K = g.K, nt = K / BK;
    unsigned voffA[2], voffB[2];
#pragma unroll
    for (int i = 0; i < 2; ++i) { int R, C; stage_rc(tid * 16 + i * 8192, R, C); const int Rb = Epi::PERM ? ((R & ~31) + perm32(R & 31)) : R;
        voffA[i] = (unsigned)(R * K + C) * 2u; voffB[i] = (unsigned)(Rb * K + C) * 2u; }
    const size_t kstep = (size_t)(BK * 2);
    const size_t hstep = (size_t)HALF * K * 2;
    const size_t tstep = 2 * hstep;
    const unsigned ldsw = (unsigned)wid * 1024u;
    const int aoff = lds_byte(wr * 64 + fr, fq * 8), boff = lds_byte(wc * 32 + fr, fq * 8);
#define PG8_SA(b, h) (((b) * 2 + (h)) * HTB)
#define PG8_SB(b, h) ((4 + (b) * 2 + (h)) * HTB)
#define PG8_STAGE(bufoff, gbase, voff) do { _Pragma("unroll") for (int _i = 0; _i < 2; ++_i) \
        __builtin_amdgcn_global_load_lds((const unsigned*)((const char*)(gbase) + (voff)[_i]), (PG8_LAS unsigned*)(lds + (bufoff) + ldsw + _i * 8192), 16, 0, 0); } while (0)
#define PG8_LDA(dst, b, h) do { _Pragma("unroll") for (int m = 0; m < 4; ++m) _Pragma("unroll") for (int k = 0; k < 2; ++k) dst[m][k] = *(const PG8_LAS bf16x8*)(lds + PG8_SA(b, h) + aoff + m * 2048 + k * 1024); } while (0)
#define PG8_LDB(dst, b, h) do { _Pragma("unroll") for (int n = 0; n < 2; ++n) _Pragma("unroll") for (int k = 0; k < 2; ++k) dst[n][k] = *(const PG8_LAS bf16x8*)(lds + PG8_SB(b, h) + boff + n * 2048 + k * 1024); } while (0)
#define PG8_MMA(ai, bj, At, Bt) do { __builtin_amdgcn_s_setprio(1); _Pragma("unroll") for (int m = 0; m < 4; ++m) _Pragma("unroll") for (int n = 0; n < 2; ++n) _Pragma("unroll") for (int k = 0; k < 2; ++k) \
        acc[ai][bj][m][n] = __builtin_amdgcn_mfma_f32_16x16x32_bf16(Bt[n][k], At[m][k], acc[ai][bj][m][n], 0, 0, 0); __builtin_amdgcn_s_setprio(0); } while (0)
#define PG8_WAIT_V(n) asm volatile("s_waitcnt vmcnt(" #n ")" ::: "memory")
#define PG8_WAIT_L(n) asm volatile("s_waitcnt lgkmcnt(" #n ")" ::: "memory")
#define PG8_BAR __builtin_amdgcn_s_barrier()
#define PG8_SCHED __builtin_amdgcn_sched_barrier(0)
    Unit cur, nxt; int ui = 0;
    if (!S.next(0, cur)) return;
    f32x4 acc[2][2][4][2];
#pragma unroll
    for (int a = 0; a < 2; ++a)
#pragma unroll
        for (int b = 0; b < 2; ++b)
#pragma unroll
            for (int m = 0; m < 4; ++m)
#pragma unroll
                for (int n = 0; n < 2; ++n) acc[a][b][m][n] = (f32x4){0.f, 0.f, 0.f, 0.f};
    bf16x8 At[4][2], B0[2][2], B1[2][2];
    const char* cA = (const char*)g.A + (size_t)cur.pm * tstep; const char* cB = (const char*)g.Bt + (size_t)cur.pn * tstep;
    S.a_ready(cur);
    if constexpr (SP2) {
        PG8_STAGE(PG8_SB(0, 0), cB, voffB); PG8_STAGE(PG8_SB(0, 1), cB + hstep, voffB); PG8_STAGE(PG8_SA(0, 0), cA, voffA); PG8_STAGE(PG8_SA(0, 1), cA + hstep, voffA);
        if (wr == 1) PG8_BAR;
        PG8_WAIT_V(2); PG8_BAR;
        PG8_STAGE(PG8_SB(1, 0), cB + kstep, voffB); PG8_STAGE(PG8_SA(1, 0), cA + kstep, voffA); PG8_STAGE(PG8_SB(1, 1), cB + hstep + kstep, voffB);
        PG8_WAIT_V(6); PG8_BAR;
    } else {
        PG8_STAGE(PG8_SB(0, 0), cB, voffB); PG8_STAGE(PG8_SA(0, 0), cA, voffA); PG8_STAGE(PG8_SB(0, 1), cB + hstep, voffB); PG8_STAGE(PG8_SA(0, 1), cA + hstep, voffA);
        if (wr == 1) PG8_BAR;
        PG8_WAIT_V(4); PG8_BAR;
        PG8_STAGE(PG8_SB(1, 0), cB + kstep, voffB); PG8_STAGE(PG8_SA(1, 0), cA + kstep, voffA); PG8_STAGE(PG8_SB(1, 1), cB + hstep + kstep, voffB);
        PG8_WAIT_V(6); PG8_BAR;
    }
    for (;;) {
        const bool has_next = S.next(ui + 1, nxt);
        const char* nA = has_next ? (const char*)g.A + (size_t)nxt.pm * tstep : cA; const char* nB = has_next ? (const char*)g.Bt + (size_t)nxt.pn * tstep : cB;
        for (int t = 0; t < nt; t += 2) {
            const bool last = (t == nt - 2);
            const char* a1 = cA + (size_t)(t + 1) * kstep;
            const char* a2 = last ? nA : cA + (size_t)(t + 2) * kstep; const char* b2 = last ? nB : cB + (size_t)(t + 2) * kstep;
            const char* a3 = a2 + kstep; const char* b3 = b2 + kstep;
            if (last && has_next) S.a_ready(nxt);
            if constexpr (SP2) {
            PG8_LDB(B0, 0, 0); PG8_LDB(B1, 0, 1); PG8_SCHED; PG8_LDA(At, 0, 0); PG8_STAGE(PG8_SA(1, 1), a1 + hstep, voffA);
            PG8_WAIT_V(8); PG8_WAIT_L(0); PG8_BAR; PG8_MMA(0, 0, At, B0); PG8_MMA(0, 1, At, B1); PG8_BAR; PG8_SCHED;
            PG8_LDA(At, 0, 1); PG8_STAGE(PG8_SB(0, 0), b2, voffB); PG8_STAGE(PG8_SB(0, 1), b2 + hstep, voffB); PG8_STAGE(PG8_SA(0, 0), a2, voffA);
            PG8_WAIT_V(8); PG8_WAIT_L(0); PG8_BAR; PG8_MMA(1, 0, At, B0); PG8_MMA(1, 1, At, B1); PG8_BAR; PG8_SCHED;
            PG8_LDB(B0, 1, 0); PG8_LDB(B1, 1, 1); PG8_SCHED; PG8_LDA(At, 1, 0); PG8_STAGE(PG8_SA(0, 1), a2 + hstep, voffA);
            PG8_WAIT_V(8); PG8_WAIT_L(0); PG8_BAR; PG8_MMA(0, 0, At, B0); PG8_MMA(0, 1, At, B1); PG8_BAR; PG8_SCHED;
            PG8_LDA(At, 1, 1); PG8_STAGE(PG8_SB(1, 0), b3, voffB); PG8_STAGE(PG8_SB(1, 1), b3 + hstep, voffB); PG8_STAGE(PG8_SA(1, 0), a3, voffA);
            PG8_WAIT_V(8); PG8_WAIT_L(0); PG8_BAR; PG8_MMA(1, 0, At, B0); PG8_MMA(1, 1, At, B1); PG8_BAR; PG8_SCHED;
            } else {
            PG8_LDB(B0, 0, 0); PG8_SCHED; PG8_LDA(At, 0, 0); PG8_STAGE(PG8_SA(1, 1), a1 + hstep, voffA);
            PG8_WAIT_L(8); PG8_BAR; PG8_WAIT_L(0); PG8_MMA(0, 0, At, B0); PG8_BAR; PG8_SCHED;
            PG8_LDB(B1, 0, 1); PG8_STAGE(PG8_SB(0, 0), b2, voffB);
            PG8_BAR; PG8_WAIT_L(0); PG8_MMA(0, 1, At, B1); PG8_BAR;
            PG8_LDA(At, 0, 1); PG8_STAGE(PG8_SA(0, 0), a2, voffA);
            PG8_BAR; PG8_WAIT_L(0); PG8_MMA(1, 0, At, B0); PG8_BAR; PG8_SCHED;
            PG8_STAGE(PG8_SB(0, 1), b2 + hstep, voffB);
            PG8_WAIT_V(6); PG8_BAR; PG8_MMA(1, 1, At, B1); PG8_BAR;
            PG8_LDB(B0, 1, 0); PG8_SCHED; PG8_LDA(At, 1, 0); PG8_STAGE(PG8_SA(0, 1), a2 + hstep, voffA);
            PG8_WAIT_L(8); PG8_BAR; PG8_WAIT_L(0); PG8_MMA(0, 0, At, B0); PG8_BAR; PG8_SCHED;
            PG8_LDB(B1, 1, 1); PG8_STAGE(PG8_SB(1, 0), b3, voffB);
            PG8_BAR; PG8_WAIT_L(0); PG8_MMA(0, 1, At, B1); PG8_BAR;
            PG8_LDA(At, 1, 1); PG8_STAGE(PG8_SA(1, 0), a3, voffA);
            PG8_BAR; PG8_WAIT_L(0); PG8_MMA(1, 0, At, B0); PG8_BAR; PG8_SCHED;
            PG8_STAGE(PG8_SB(1, 1), b3 + hstep, voffB);
            PG8_WAIT_V(6); PG8_BAR; PG8_MMA(1, 1, At, B1); PG8_BAR;
            }
        }
        if constexpr (ALIGN_EPI) { if (wr == 0) PG8_BAR; }
        if constexpr (!Epi::AFTER_DRAIN) { E(acc, cur, wr, wc, fr, fq); S.done(cur); }
        if (!has_next) break;
#pragma unroll
        for (int a = 0; a < 2; ++a)
#pragma unroll
            for (int b = 0; b < 2; ++b)
#pragma unroll
                for (int m = 0; m < 4; ++m)
#pragma unroll
                    for (int n = 0; n < 2; ++n) acc[a][b][m][n] = (f32x4){0.f, 0.f, 0.f, 0.f};
        cur = nxt; cA = nA; cB = nB; ++ui;
        if constexpr (ALIGN_EPI) { if (wr == 1) PG8_BAR; }
    }
    PG8_WAIT_V(0);
    if constexpr (!ALIGN_EPI) { if (wr == 0) PG8_BAR; }
    PG8_BAR;
    if constexpr (Epi::AFTER_DRAIN) { E.fused(acc, cur, wr, wc, fr, fq, lds, wid, lane); S.done(cur); }
#undef PG8_SA
#undef PG8_SB
#undef PG8_STAGE
#undef PG8_LDA
#undef PG8_LDB
#undef PG8_MMA
#undef PG8_WAIT_V
#undef PG8_WAIT_L
#undef PG8_BAR
#undef PG8_SCHED
}
}

#ifndef PG8_SP2
#define PG8_SP2 true
#endif
#ifndef PG8_ALIGN
#define PG8_ALIGN true
#endif
constexpr int NWAVES = 8;
#ifndef MK_N_LAUNCHES
#define MK_N_LAUNCHES 1
#endif
#ifndef EN_CROSS
#define EN_CROSS 1
#endif
#ifndef EN_DIFF
#define EN_DIFF 1
#endif
#ifndef EN_MLSTM
#define EN_MLSTM 1
#endif
constexpr int N_PHASES = 7;

constexpr int BATCH = 8, SEQ = 4096, DM = 1024, M = BATCH * SEQ, INW = 4608, MIXW = 1536, MEML = 256, MEMROWS = BATCH * MEML;
constexpr int NH = 4, HD = 128, LCH = 128, NCH = SEQ / LCH;
constexpr int C_XM = 0, C_OM = 512, C_ZM = 1024, C_QD = 1536, C_KD = 2048, C_VD = 2560, C_ZD = 3072, C_QC = 3584, C_ZC = 4096;
constexpr float NORM_EPS = 1e-6f;

constexpr size_t KiB = 1024, MiB = 1u << 20;
constexpr size_t WS_CTL = 0, CTL_ZERO_BYTES = 1 * MiB;
constexpr size_t WS_ROWSS = 1 * MiB;
constexpr size_t WS_WG = 1 * MiB + 128 * KiB;
constexpr size_t WS_MLOC = 1 * MiB + 192 * KiB, WS_BEND = WS_MLOC + 4 * KiB, WS_MIN = WS_MLOC + 8 * KiB;
constexpr size_t WS_NLOC = 2 * MiB, WS_NIN = 2 * MiB + 512 * KiB;
constexpr size_t WS_BB = 3 * MiB, WS_U = 3 * MiB + 512 * KiB, WS_CU = 4 * MiB;
constexpr size_t WS_WQKV = 5 * MiB;
constexpr size_t WS_WIN = 6 * MiB;
constexpr size_t WS_WOUT = 15 * MiB;
constexpr size_t WS_WMEM = 18 * MiB;
constexpr size_t WS_MEMN = 20 * MiB;
constexpr size_t WS_MEMKV = 24 * MiB;
constexpr size_t WS_CIN = 32 * MiB;
constexpr size_t WS_H = 64 * MiB;
constexpr size_t WS_CLOC = WS_H;
constexpr size_t WS_P = 128 * MiB;
constexpr size_t WS_Y = 416 * MiB;
constexpr size_t WS_END = 512 * MiB;
static_assert(WS_P + (size_t)M * INW * 2 == WS_Y && WS_Y + (size_t)M * MIXW * 2 == WS_END, "ws map");
constexpr int CW_TMO = 0, CW_CODE = 1, CW_BAR = 4096;

constexpr int RING_OFF = 0, RING_BYTES = 131072;
constexpr int PHM_OFF = RING_BYTES;
constexpr int LDS_BYTES = 147456;
constexpr int LDSCTL_OFF = LDS_BYTES - 512, MISC_OFF = LDSCTL_OFF;

#define GAS __attribute__((address_space(1)))
#define LAS __attribute__((address_space(3)))
typedef unsigned short bf16;
typedef unsigned v4u __attribute__((ext_vector_type(4)));
typedef unsigned v2u __attribute__((ext_vector_type(2)));
typedef float f32x4 __attribute__((ext_vector_type(4)));
typedef float f32x2 __attribute__((ext_vector_type(2)));
typedef float f32x16 __attribute__((ext_vector_type(16)));
typedef short bf16x8 __attribute__((ext_vector_type(8)));
typedef short s16x4 __attribute__((ext_vector_type(4)));
typedef __bf16 bf16x2_t __attribute__((ext_vector_type(2)));
typedef GAS unsigned gu32;
typedef GAS unsigned long long gu64;
typedef LAS unsigned char lds8;
#define RLX_AGENT __ATOMIC_RELAXED, __HIP_MEMORY_SCOPE_AGENT
#define LDS_WAIT() asm volatile("s_waitcnt lgkmcnt(0)" ::: "memory")
#define VM_WAIT() asm volatile("s_waitcnt vmcnt(0)" ::: "memory")
#define MFMA32(a, b, c) __builtin_amdgcn_mfma_f32_32x32x16_bf16(a, b, c, 0, 0, 0)
__device__ __forceinline__ unsigned pk2(float lo, float hi) { f32x2 v = {lo, hi}; bf16x2_t b = __builtin_convertvector(v, bf16x2_t); return __builtin_bit_cast(unsigned, b); }
__device__ __forceinline__ float bflo(unsigned w) { return __uint_as_float(w << 16); }
__device__ __forceinline__ float bfhi(unsigned w) { return __uint_as_float(w & 0xffff0000u); }
__device__ __forceinline__ float bf2f(bf16 b) { return __uint_as_float((unsigned)b << 16); }
__device__ __forceinline__ bf16 f2bf(float f) { return (bf16)(pk2(f, 0.f) & 0xffffu); }
__device__ __forceinline__ int crow(int r, int hi) { return (r & 3) + 8 * (r >> 2) + 4 * hi; }
__device__ __forceinline__ float sigmoidf_(float x) { return 1.f / (1.f + __expf(-x)); }
__device__ __forceinline__ float siluf_(float x) { return x / (1.f + __expf(-x)); }
__device__ __forceinline__ int swz(int row, int chunk) { return row * 256 + ((chunk ^ (row & 15)) << 4); }
__device__ __forceinline__ bf16x8 ldfrag(const lds8* p) { return *(const LAS bf16x8*)p; }
__device__ __forceinline__ bf16x8 pack8(const f32x16& p, int b) { v4u w; w.x = pk2(p[b], p[b + 1]); w.y = pk2(p[b + 2], p[b + 3]); w.z = pk2(p[b + 4], p[b + 5]); w.w = pk2(p[b + 6], p[b + 7]); return __builtin_bit_cast(bf16x8, w); }
typedef short v4i16_t __attribute__((ext_vector_type(4)));
__device__ __forceinline__ s16x4 vtr(const lds8* p) { return __builtin_bit_cast(s16x4, __builtin_amdgcn_ds_read_tr16_b64_v4i16((LAS v4i16_t*)p)); }
#define XB_TMO      128
#define XB_XCNT(j)  (256  + 64 * (j))
#define XB_XSUB(j)  (1280 + 64 * (j))
#define XB_XGEN(j)  (2304 + 64 * (j))
#define XB_TOP      3328
#define XB_TOPGEN   3392
#define XCD_BAR_WORDS 3456
#define XB_SPIN_CAP (1u << 18)

__device__ __forceinline__ unsigned xb_ld(unsigned* p)              { return __hip_atomic_load(p, __ATOMIC_RELAXED, __HIP_MEMORY_SCOPE_AGENT); }
__device__ __forceinline__ unsigned xb_add(unsigned* p, unsigned v) { return __hip_atomic_fetch_add(p, v, __ATOMIC_RELAXED, __HIP_MEMORY_SCOPE_AGENT); }
__device__ __forceinline__ unsigned xb_xcc_id() { return (unsigned)__builtin_amdgcn_s_getreg((3 << 11) | 20) & 0xFu; }
#define XB_SPIN(cond, bar) do { unsigned _sp = 0; while (cond) { __builtin_amdgcn_s_sleep(1); \
    if ((++_sp & 255u) == 0u) { if (xb_ld(&(bar)[XB_TMO])) break; if (_sp > XB_SPIN_CAP) { atomicAdd(&(bar)[XB_TMO], 1u); break; } } } } while (0)

struct XcdBarrier {
    unsigned* bar; unsigned x;
    volatile LAS unsigned* st;
};

__device__ __forceinline__ XcdBarrier xcd_barrier_post(unsigned* bar, volatile LAS unsigned* st) {
    XcdBarrier b; b.bar = bar; b.x = xb_xcc_id(); b.st = st;
    if (threadIdx.x == 0) (void)xb_add(&bar[XB_XCNT(b.x)], 1u);
    return b;
}
__device__ __forceinline__ void xcd_barrier_complete(unsigned* bar, unsigned x, unsigned& nloc, unsigned& nx) {
    const unsigned G = gridDim.x * gridDim.y * gridDim.z;
    unsigned sum, cnt, mine, sp = 0u;
    for (;;) {
        sum = 0u; cnt = 0u; mine = 0u;
#pragma unroll
        for (unsigned j = 0; j < 16; ++j) { const unsigned c = xb_ld(&bar[XB_XCNT(j)]); sum += c; cnt += (c > 0u) ? 1u : 0u; mine = (j == x) ? c : mine; }
        if (sum == G) break;
        __builtin_amdgcn_s_sleep(1);
        if ((++sp & 255u) == 0u) { if (xb_ld(&bar[XB_TMO])) break; if (sp > XB_SPIN_CAP) { atomicAdd(&bar[XB_TMO], 1u); break; } }
    }
    nloc = mine > 0u ? mine : 1u; nx = cnt > 0u ? cnt : 1u;
}

__device__ __forceinline__ void xcd_barrier(const XcdBarrier& b) {
    asm volatile("s_waitcnt vmcnt(0)" ::: "memory");
    __syncthreads();
    if (threadIdx.x == 0) {
        unsigned* bar = b.bar;
        __builtin_amdgcn_s_waitcnt(0);
        unsigned nloc = b.st[0], nx = b.st[1];
        if (nloc == 0u) { xcd_barrier_complete(bar, b.x, nloc, nx); b.st[0] = nloc; b.st[1] = nx; }
        const unsigned old = xb_add(&bar[XB_XSUB(b.x)], 1u);
        const unsigned gen = old / nloc;
        if (old + 1u == (gen + 1u) * nloc) {
            __builtin_amdgcn_fence(__ATOMIC_RELEASE, "agent");
            asm volatile("s_waitcnt vmcnt(0)" ::: "memory");
            const unsigned og = xb_add(&bar[XB_TOP], 1u);
            const unsigned tg = og / nx;
            if (og + 1u == (tg + 1u) * nx) xb_add(&bar[XB_TOPGEN], 1u);
            else XB_SPIN(xb_ld(&bar[XB_TOPGEN]) == tg, bar);
            __builtin_amdgcn_fence(__ATOMIC_ACQUIRE, "agent");
            xb_add(&bar[XB_XGEN(b.x)], 1u);
            asm volatile("s_waitcnt vmcnt(0)" ::: "memory");
        } else {
            XB_SPIN(xb_ld(&bar[XB_XGEN(b.x)]) == gen, bar);
            __builtin_amdgcn_fence(__ATOMIC_ACQUIRE, "agent");
            asm volatile("s_waitcnt vmcnt(0)" ::: "memory");
        }
    }
    __syncthreads();
}

struct Frame {
    lds8* lds;
    volatile LAS unsigned* MISC;
    gu32* ctl;
    int tid, lane, wave, vcu, G;
    const float *x, *mem, *norm_g, *w_in, *conv_w, *conv_b, *wq_m, *wk_m, *wv_m, *w_if, *b_if, *mnorm_g, *skip_m, *lam_q1, *lam_k1, *lam_q2, *lam_k2, *dnorm_g, *mem_norm_g, *w_mem_kv, *w_out, *final_g;
    float* out; unsigned char* ws;
};
__device__ __forceinline__ float wave_sum(float v) {
#pragma unroll
    for (int o = 1; o < 64; o <<= 1) v += __shfl_xor(v, o);
    return v;
}
__device__ __forceinline__ void p0_transpose_item(const float* W, int K, int N, bf16* WT, int row_off, LAS float* scr, int item, int lane, const float* gk) {
    const int nblk = N / 32, kb = item / nblk, nb = item % nblk, k0 = 64 * kb, n0 = 32 * nb;
#pragma unroll 8
    for (int i = 0; i < 32; ++i) { const int kk = 2 * i + (lane >> 5); scr[kk * 33 + (lane & 31)] = W[(size_t)(k0 + kk) * N + n0 + (lane & 31)]; }
    LDS_WAIT(); asm volatile("" ::: "memory");
    const int c = lane & 7;
    float g[8];
#pragma unroll
    for (int j = 0; j < 8; ++j) g[j] = gk ? gk[k0 + 8 * c + j] : 1.f;
#pragma unroll
    for (int j = 0; j < 4; ++j) { const int n = (lane >> 3) + 8 * j; const LAS float* s = scr + (8 * c) * 33 + n;
        v4u o; o.x = pk2(s[0 * 33] * g[0], s[1 * 33] * g[1]); o.y = pk2(s[2 * 33] * g[2], s[3 * 33] * g[3]); o.z = pk2(s[4 * 33] * g[4], s[5 * 33] * g[5]); o.w = pk2(s[6 * 33] * g[6], s[7 * 33] * g[7]);
        *(GAS v4u*)(WT + (size_t)(row_off + n0 + n) * K + k0 + 8 * c) = o; }
    LDS_WAIT(); asm volatile("" ::: "memory");
}
__device__ __forceinline__ void rms_row_to_bf16(int lane, const float* xrow, bf16* orow) {
    const GAS f32x4* xr = (const GAS f32x4*)xrow + lane;
    f32x4 v[4]; float s = 0.f;
#pragma unroll
    for (int j = 0; j < 4; ++j) { v[j] = xr[64 * j]; s += (v[j].x * v[j].x + v[j].y * v[j].y) + (v[j].z * v[j].z + v[j].w * v[j].w); }
    const float rstd = 1.f / sqrtf(wave_sum(s) * (1.f / DM) + NORM_EPS);
    GAS v2u* o8 = (GAS v2u*)orow + lane;
#pragma unroll
    for (int j = 0; j < 4; ++j) { v2u w; w.x = pk2(v[j].x * rstd, v[j].y * rstd); w.y = pk2(v[j].z * rstd, v[j].w * rstd); o8[64 * j] = w; }
}
__device__ __forceinline__ void p0_prologue(Frame& F) {
    LAS float* scr = (LAS float*)(F.lds + RING_OFF + F.wave * 16384);
    const int gw = F.vcu * NWAVES + F.wave, NGW = F.G * NWAVES;
    bf16* WIN = (bf16*)(F.ws + WS_WIN); bf16* WOUT = (bf16*)(F.ws + WS_WOUT); bf16* WMEM = (bf16*)(F.ws + WS_WMEM); bf16* WQKV = (bf16*)(F.ws + WS_WQKV);
    constexpr int I_IN = (DM / 64) * (INW / 32), I_OUT = (MIXW / 64) * (DM / 32), I_MEM = (DM / 64) * (DM / 32), I_HEAD = (HD / 64) * (HD / 32);
    constexpr int NITEMS = I_IN + I_OUT + I_MEM + 12 * I_HEAD;
    for (int it = gw; it < NITEMS; it += NGW) {
        int r = it;
        if (r < I_IN) { p0_transpose_item(F.w_in, DM, INW, WIN, 0, scr, r, F.lane, F.norm_g); continue; } r -= I_IN;
        if (r < I_OUT) { p0_transpose_item(F.w_out, MIXW, DM, WOUT, 0, scr, r, F.lane, nullptr); continue; } r -= I_OUT;
        if (r < I_MEM) { p0_transpose_item(F.w_mem_kv, DM, DM, WMEM, 0, scr, r, F.lane, F.mem_norm_g); continue; } r -= I_MEM;
        const int mh = r / I_HEAD, sub = r % I_HEAD, mat = mh >> 2, hh = mh & 3;
        if (mat == 0) p0_transpose_item(F.wq_m + (size_t)hh * HD * HD, HD, HD, WQKV + (size_t)mh * HD * HD, 0, scr, sub, F.lane, nullptr);
        else if (mat == 1) p0_transpose_item(F.wk_m + (size_t)hh * HD * HD, HD, HD, WQKV + (size_t)mh * HD * HD, 0, scr, sub, F.lane, nullptr);
        else p0_transpose_item(F.wv_m + (size_t)hh * HD * HD, HD, HD, WQKV + (size_t)mh * HD * HD, 0, scr, sub, F.lane, nullptr);
    }
    bf16* Hb = (bf16*)(F.ws + WS_H); bf16* MEMN = (bf16*)(F.ws + WS_MEMN);
    for (int m = gw; m < M + MEMROWS; m += NGW) {
        if (m < M) rms_row_to_bf16(F.lane, F.x + (size_t)m * DM, Hb + (size_t)m * DM);
        else rms_row_to_bf16(F.lane, F.mem + (size_t)(m - M) * DM, MEMN + (size_t)(m - M) * DM);
    }
    const int gt = F.vcu * (NWAVES * 64) + F.tid, NGT = F.G * NWAVES * 64;
    float* ROWSS = (float*)(F.ws + WS_ROWSS);
    for (int i = gt; i < M; i += NGT) ROWSS[i] = 0.f;
    float* WG = (float*)(F.ws + WS_WG);
    for (int i = gt; i < 2 * 512 * 8; i += NGT) {
        const int which = i >> 12, hd = (i >> 3) & 511, g = i & 7, hh = hd >> 7, d = hd & 127; float s = 0.f;
        if (which == 0) { const float* q = F.wq_m + ((size_t)hh * HD + d) * HD; const float* k = F.wk_m + ((size_t)hh * HD + d) * HD;
            for (int e = 0; e < HD; ++e) s += q[e] * F.w_if[(hh * HD + e) * 8 + g] + k[e] * F.w_if[(512 + hh * HD + e) * 8 + g]; }
        else { const float* v = F.wv_m + ((size_t)hh * HD + d) * HD; for (int e = 0; e < HD; ++e) s += v[e] * F.w_if[(1024 + hh * HD + e) * 8 + g]; }
        WG[i] = s;
    }
#if !(EN_CROSS && EN_DIFF && EN_MLSTM)
    { v4u* Y4 = (v4u*)(F.ws + WS_Y); const size_t n16 = (size_t)M * MIXW * 2 / 16; for (size_t i = gt; i < n16; i += NGT) Y4[i] = (v4u){0u, 0u, 0u, 0u}; }
#endif
}

namespace att {
constexpr int L_K = 0, L_V = 16384, L_WS = 32768, L_XO = 34816, L_END = L_XO + 65536;
static_assert(L_END <= RING_BYTES, "attention LDS");
__device__ __forceinline__ void stage_kv(lds8* lds, const bf16* Kg, int pitchK, const bf16* Vg, int pitchV, int wave, int lane) {
    v4u kv[2], vv[2];
#pragma unroll
    for (int i = 0; i < 2; ++i) { const int chunk = wave + 8 * i; kv[i] = *(const GAS v4u*)(Kg + (size_t)lane * pitchK + chunk * 8); }
#pragma unroll
    for (int i = 0; i < 2; ++i) { const int p = wave + 8 * i, d0 = p >> 2, key = 16 * (p & 3) + (lane >> 2); vv[i] = *(const GAS v4u*)(Vg + (size_t)key * pitchV + d0 * 32 + (lane & 3) * 8); }
#pragma unroll
    for (int i = 0; i < 2; ++i) { const int chunk = wave + 8 * i; *(LAS v4u*)(lds + L_K + (chunk * 64 + lane) * 16) = kv[i]; }
#pragma unroll
    for (int i = 0; i < 2; ++i) { const int p = wave + 8 * i; *(LAS v4u*)(lds + L_V + p * 1024 + lane * 16) = vv[i]; }
}
template <int NQ, bool MASK>
__device__ __forceinline__ void tile_step(lds8* lds, const bf16x8* qf, int kchunk0, float C2, int kbase, int qg, float& m, float& l, f32x16* o, volatile LAS float* wsf, int lane) {
    const int r32 = lane & 31, hi = lane >> 5;
    f32x16 p0 = {}, p1 = {};
#pragma unroll
    for (int d0 = 0; d0 < NQ; ++d0) {
        const lds8* kp = lds + L_K + ((kchunk0 + 2 * d0 + hi) * 64 + r32) * 16;
        const bf16x8 a0 = ldfrag(kp), a1 = ldfrag(kp + 512);
        p0 = MFMA32(a0, qf[d0], p0); p1 = MFMA32(a1, qf[d0], p1);
    }
    float tmax = -1e30f;
#pragma unroll
    for (int r = 0; r < 16; ++r) { float s0 = p0[r] * C2, s1 = p1[r] * C2;
        if (MASK) { const int k0 = kbase + crow(r, hi); if (k0 > qg) s0 = -1e30f; if (k0 + 32 > qg) s1 = -1e30f; }
        p0[r] = s0; p1[r] = s1; tmax = fmaxf(tmax, fmaxf(s0, s1)); }
    tmax = fmaxf(tmax, __shfl_xor(tmax, 32));
    const float mnew = fmaxf(m, tmax), alpha = __builtin_amdgcn_exp2f(m - mnew); m = mnew;
    float ls = 0.f;
#pragma unroll
    for (int r = 0; r < 16; ++r) { p0[r] = __builtin_amdgcn_exp2f(p0[r] - mnew); p1[r] = __builtin_amdgcn_exp2f(p1[r] - mnew); ls += p0[r] + p1[r]; }
    l = l * alpha + ls;
    if (hi == 0) wsf[r32] = alpha;
#pragma unroll
    for (int r = 0; r < 16; ++r) { const float a = wsf[crow(r, hi)];
#pragma unroll
        for (int d0 = 0; d0 < 4; ++d0) o[d0][r] *= a; }
    bf16x8 pa[4]; pa[0] = pack8(p0, 0); pa[1] = pack8(p0, 8); pa[2] = pack8(p1, 0); pa[3] = pack8(p1, 8);
    const lds8* vb = lds + L_V + ((lane >> 4) & 1) * 32 + (lane & 3) * 8 + (4 * hi + ((lane & 15) >> 2)) * 64;
#pragma unroll
    for (int d0 = 0; d0 < 4; ++d0)
#pragma unroll
        for (int ks = 0; ks < 4; ++ks) { const s16x4 lo = vtr(vb + d0 * 4096 + ks * 1024), hh = vtr(vb + d0 * 4096 + ks * 1024 + 512);
            const bf16x8 vf = (bf16x8){lo[0], lo[1], lo[2], lo[3], hh[0], hh[1], hh[2], hh[3]};
            o[d0] = MFMA32(pa[ks], vf, o[d0]); }
}
__device__ __forceinline__ void finish_o(float l, f32x16* o, volatile LAS float* wsf, int lane) {
    const int r32 = lane & 31, hi = lane >> 5;
    l += __shfl_xor(l, 32);
    if (hi == 0) wsf[32 + r32] = 1.f / l;
#pragma unroll
    for (int r = 0; r < 16; ++r) { const float a = wsf[32 + crow(r, hi)];
#pragma unroll
        for (int d0 = 0; d0 < 4; ++d0) o[d0][r] *= a; }
}
__device__ __forceinline__ void cross_unit(Frame& F, int b, int h, int qblk) {
    int tid_ = F.tid; asm volatile("" : "+v"(tid_));
    lds8* lds = F.lds + RING_OFF; const int lane = tid_ & 63, wave = __builtin_amdgcn_readfirstlane(tid_ >> 6), r32 = lane & 31, hi = lane >> 5;
    const bf16* P = (const bf16*)(F.ws + WS_P); const bf16* MKV = (const bf16*)(F.ws + WS_MEMKV); bf16* Y = (bf16*)(F.ws + WS_Y);
    const int row0 = b * SEQ + qblk * 256 + 32 * wave;
    bf16x8 qf[8];
#pragma unroll
    for (int d0 = 0; d0 < 8; ++d0) qf[d0] = *(const GAS bf16x8*)(P + (size_t)(row0 + r32) * INW + C_QC + h * HD + d0 * 16 + hi * 8);
    float m = -1e30f, l = 0.f; f32x16 o[4];
#pragma unroll
    for (int d0 = 0; d0 < 4; ++d0) o[d0] = f32x16{};
    volatile LAS float* wsf = (volatile LAS float*)(lds + L_WS) + wave * 64;
    const float C2 = 0.08838834764831845f * 1.4426950408889634f;
    for (int kt = 0; kt < MEML / 64; ++kt) {
        __syncthreads();
        const bf16* Kg = MKV + (size_t)(b * MEML + kt * 64) * DM + h * HD;
        stage_kv(lds, Kg, DM, Kg + 512, DM, wave, lane);
        __syncthreads();
        tile_step<8, false>(lds, qf, 0, C2, 0, 0, m, l, o, wsf, lane);
    }
    finish_o(l, o, wsf, lane);
#pragma unroll
    for (int r = 0; r < 16; ++r) { const size_t row = (size_t)(row0 + crow(r, hi));
#pragma unroll
        for (int d0 = 0; d0 < 4; ++d0) { const int col = h * HD + 32 * d0 + r32; const float z = bf2f(P[row * INW + C_ZC + col]);
            Y[row * MIXW + 1024 + col] = f2bf(o[d0][r] * siluf_(z)); } }
}
__device__ __forceinline__ void diff_unit(Frame& F, int b, int h, int qb, float lam) {
    int tid_ = F.tid; asm volatile("" : "+v"(tid_));
    lds8* lds = F.lds + RING_OFF; const int lane = tid_ & 63, wave = __builtin_amdgcn_readfirstlane(tid_ >> 6), r32 = lane & 31, hi = lane >> 5, map = wave >> 2, wq = wave & 3;
    const bf16* P = (const bf16*)(F.ws + WS_P); bf16* Y = (bf16*)(F.ws + WS_Y);
    const int q0 = qb * 128, row0 = b * SEQ + q0 + 32 * wq, NT = 2 * (qb + 1);
    bf16x8 qf[4];
#pragma unroll
    for (int d0 = 0; d0 < 4; ++d0) qf[d0] = *(const GAS bf16x8*)(P + (size_t)(row0 + r32) * INW + C_QD + h * HD + map * 64 + d0 * 16 + hi * 8);
    float m = -1e30f, l = 0.f; f32x16 o[4];
#pragma unroll
    for (int d0 = 0; d0 < 4; ++d0) o[d0] = f32x16{};
    volatile LAS float* wsf = (volatile LAS float*)(lds + L_WS) + wave * 64;
    const float C2 = 0.125f * 1.4426950408889634f;
    const int qg = q0 + 32 * wq + r32;
    for (int kt = 0; kt < NT; ++kt) {
        __syncthreads();
        const bf16* Kg = P + (size_t)(b * SEQ + kt * 64) * INW + C_KD + h * HD;
        const bf16* Vg = P + (size_t)(b * SEQ + kt * 64) * INW + C_VD + h * HD;
        stage_kv(lds, Kg, INW, Vg, INW, wave, lane);
        __syncthreads();
        if (kt >= NT - 2) tile_step<4, true>(lds, qf, 8 * map, C2, kt * 64, qg, m, l, o, wsf, lane);
        else tile_step<4, false>(lds, qf, 8 * map, C2, 0, 0, m, l, o, wsf, lane);
    }
    finish_o(l, o, wsf, lane);
    LAS float* XO = (LAS float*)(lds + L_XO);
    if (map == 1) {
#pragma unroll
        for (int d0 = 0; d0 < 4; ++d0)
#pragma unroll
            for (int r = 0; r < 16; ++r) XO[((wq * 4 + d0) * 16 + r) * 64 + lane] = o[d0][r];
    }
    __syncthreads();
    if (map == 0) {
#pragma unroll
        for (int r = 0; r < 16; ++r) { float ss = 0.f;
#pragma unroll
            for (int d0 = 0; d0 < 4; ++d0) { const float od = o[d0][r] - lam * XO[((wq * 4 + d0) * 16 + r) * 64 + lane]; o[d0][r] = od; ss += od * od; }
            ss += __shfl_xor(ss, 1); ss += __shfl_xor(ss, 2); ss += __shfl_xor(ss, 4); ss += __shfl_xor(ss, 8); ss += __shfl_xor(ss, 16);
            const float rinv = rsqrtf(ss * (1.f / HD) + NORM_EPS) * 0.8f;
            const size_t row = (size_t)(row0 + crow(r, hi));
#pragma unroll
            for (int d0 = 0; d0 < 4; ++d0) { const int col = h * HD + 32 * d0 + r32; const float z = bf2f(P[row * INW + C_ZD + col]);
                Y[row * MIXW + 512 + col] = f2bf(o[d0][r] * rinv * F.dnorm_g[col] * siluf_(z)); } }
    }
}
}

namespace ml {
constexpr int L_XC = 0, L_XM = 32768, L_KT = 65536, L_VT = 98304;
constexpr float KSCALE = 0.08838834764831845f;
__device__ __forceinline__ void stage_conv(lds8* XC, lds8* XM, const bf16* P, int b, int c, int h, const float* conv_w, const float* conv_b, int tid) {
#pragma unroll
    for (int i = 0; i < 4; ++i) {
        const int item = tid + 512 * i, t = item >> 4, ch = item & 15, s = c * LCH + t, col = h * HD + ch * 8;
        const bf16* src = P + (size_t)(b * SEQ + s) * INW + C_XM + col;
        const v4u zero = (v4u){0u, 0u, 0u, 0u};
        const v4u r3 = *(const GAS v4u*)src;
        const v4u r2 = s >= 1 ? *(const GAS v4u*)(src - INW) : zero;
        const v4u r1 = s >= 2 ? *(const GAS v4u*)(src - 2 * INW) : zero;
        const v4u r0 = s >= 3 ? *(const GAS v4u*)(src - 3 * INW) : zero;
        float y[8];
#pragma unroll
        for (int e = 0; e < 8; ++e) { const int cc = col + e; const unsigned w0 = r0[e >> 1], w1 = r1[e >> 1], w2 = r2[e >> 1], w3 = r3[e >> 1];
            const float x0 = (e & 1) ? bfhi(w0) : bflo(w0), x1 = (e & 1) ? bfhi(w1) : bflo(w1), x2 = (e & 1) ? bfhi(w2) : bflo(w2), x3 = (e & 1) ? bfhi(w3) : bflo(w3);
            const float v = conv_b[cc] + conv_w[cc] * x0 + conv_w[512 + cc] * x1 + conv_w[1024 + cc] * x2 + conv_w[1536 + cc] * x3;
            y[e] = siluf_(v); }
        v4u o; o.x = pk2(y[0], y[1]); o.y = pk2(y[2], y[3]); o.z = pk2(y[4], y[5]); o.w = pk2(y[6], y[7]);
        *(LAS v4u*)(XC + swz(t, ch)) = o; *(LAS v4u*)(XM + swz(t, ch)) = r3;
    }
}
__device__ __forceinline__ float logsig(float f) { return fminf(f, 0.f) - log1pf(__expf(-fabsf(f))); }
__device__ __forceinline__ void store_accT(lds8* T, const f32x16& acc, int ib, int jb, int r32, int hi) {
#pragma unroll
    for (int rq = 0; rq < 4; ++rq) { v2u w; w.x = pk2(acc[4 * rq], acc[4 * rq + 1]); w.y = pk2(acc[4 * rq + 2], acc[4 * rq + 3]);
        *(LAS v2u*)(T + swz(32 * jb + r32, 4 * ib + rq) + 8 * hi) = w; }
}
__device__ __forceinline__ void m1_unit(Frame& F, int b, int c) {
    lds8* lds = F.lds + RING_OFF; lds8 *XC = lds + L_XC, *XM = lds + L_XM, *KT = lds + L_KT, *VT = lds + L_VT;
    LAS float* GA = (LAS float*)(F.lds + PHM_OFF); LAS float* WA = GA + 1024; LAS float* NL = WA + 512;
    int tid = F.tid; asm volatile("" : "+v"(tid));
    const int lane = tid & 63, wave = __builtin_amdgcn_readfirstlane(tid >> 6), r32 = lane & 31, hi = lane >> 5;
    const bf16* P = (const bf16*)(F.ws + WS_P); const float* WG = (const float*)(F.ws + WS_WG); const bf16* WQKV = (const bf16*)(F.ws + WS_WQKV);
    float* BBg = (float*)(F.ws + WS_BB); float* Ug = (float*)(F.ws + WS_U); float* CUg = (float*)(F.ws + WS_CU);
    float* MLOC = (float*)(F.ws + WS_MLOC); float* BEND = (float*)(F.ws + WS_BEND); float* NLOC = (float*)(F.ws + WS_NLOC); float* CLOC = (float*)(F.ws + WS_CLOC);
    const int t = tid & 127, gq = tid >> 7;
    float ga0 = 0.f, ga1 = 0.f;
    for (int h = 0; h < NH; ++h) {
        __syncthreads();
        stage_conv(XC, XM, P, b, c, h, F.conv_w, F.conv_b, tid);
        __syncthreads();
        for (int ch = 0; ch < 16; ++ch) { const v4u xc = *(const LAS v4u*)(XC + swz(t, ch)), xm = *(const LAS v4u*)(XM + swz(t, ch));
#pragma unroll
            for (int e = 0; e < 8; ++e) { const int d = h * HD + ch * 8 + e; const float a = (e & 1) ? bfhi(xc[e >> 1]) : bflo(xc[e >> 1]), bm = (e & 1) ? bfhi(xm[e >> 1]) : bflo(xm[e >> 1]);
                const f32x2 wc = *(const GAS f32x2*)(WG + d * 8 + 2 * gq), wm = *(const GAS f32x2*)(WG + 4096 + d * 8 + 2 * gq);
                ga0 += a * wc.x + bm * wm.x; ga1 += a * wc.y + bm * wm.y; } }
    }
    GA[t * 8 + 2 * gq] = ga0 + F.b_if[2 * gq]; GA[t * 8 + 2 * gq + 1] = ga1 + F.b_if[2 * gq + 1];
    __syncthreads();
    if (wave < 4) {
        const int hd = wave, t0 = 2 * lane, t1 = t0 + 1;
        const float i0 = GA[t0 * 8 + hd], i1 = GA[t1 * 8 + hd], lf0 = logsig(GA[t0 * 8 + 4 + hd]), lf1 = logsig(GA[t1 * 8 + 4 + hd]);
        const float ps = lf0 + lf1; float xs = ps;
#pragma unroll
        for (int o = 1; o < 64; o <<= 1) { const float y = __shfl_up(xs, o); if (lane >= o) xs += y; }
        const float excl = xs - ps, bb0 = excl + lf0, bb1 = excl + ps, u0 = i0 - bb0, u1 = i1 - bb1;
        float xm = fmaxf(u0, u1);
#pragma unroll
        for (int o = 1; o < 64; o <<= 1) { const float y = __shfl_up(xm, o); if (lane >= o) xm = fmaxf(xm, y); }
        float ex = __shfl_up(xm, 1); if (lane == 0) ex = -1e30f;
        const float cu0 = fmaxf(ex, u0), cu1 = fmaxf(cu0, u1);
        const float umax = __shfl(xm, 63), bend = __shfl(bb1, 63);
        WA[hd * 128 + t0] = __expf(u0 - umax); WA[hd * 128 + t1] = __expf(u1 - umax);
        const size_t idx = (size_t)(b * NH + hd) * SEQ + c * LCH + t0;
        *(f32x2*)(BBg + idx) = (f32x2){bb0, bb1}; *(f32x2*)(Ug + idx) = (f32x2){u0, u1}; *(f32x2*)(CUg + idx) = (f32x2){cu0, cu1};
        if (lane == 0) { MLOC[(b * NH + hd) * NCH + c] = bend + umax; BEND[(b * NH + hd) * NCH + c] = bend; }
    }
    const int tb = wave & 3, eh = wave >> 2, u0i = (b * NCH + c) * NH;
    for (int h = 0; h < NH; ++h) {
        __syncthreads();
        if (tid < 128) NL[tid] = 0.f;
        stage_conv(XC, XM, P, b, c, h, F.conv_w, F.conv_b, tid);
        __syncthreads();
        float wa16[16];
#pragma unroll
        for (int r = 0; r < 16; ++r) wa16[r] = WA[h * 128 + 32 * tb + crow(r, hi)];
#pragma unroll
        for (int mat = 1; mat < 3; ++mat) {
            const lds8* XS = (mat == 1) ? XC : XM; const bf16* WT = WQKV + (size_t)(mat * 4 + h) * HD * HD;
#pragma unroll
            for (int ebi = 0; ebi < 2; ++ebi) { const int eb = 2 * eh + ebi; f32x16 acc = {};
#pragma unroll
                for (int ds = 0; ds < 8; ++ds) { const bf16x8 A = ldfrag(XS + swz(32 * tb + r32, 2 * ds + hi)); const bf16x8 B = *(const GAS bf16x8*)(WT + (size_t)(32 * eb + r32) * HD + 16 * ds + 8 * hi);
                    acc = MFMA32(A, B, acc); }
                if (mat == 1) { float nl = 0.f;
#pragma unroll
                    for (int r = 0; r < 16; ++r) { acc[r] *= KSCALE; nl += acc[r] * wa16[r]; }
                    nl += __shfl_xor(nl, 32); if (hi == 0) atomicAdd((float*)(NL + 32 * eb + r32), nl);
                    store_accT(KT, acc, tb, eb, r32, hi);
                } else {
#pragma unroll
                    for (int r = 0; r < 16; ++r) acc[r] *= wa16[r];
                    store_accT(VT, acc, tb, eb, r32, hi);
                } }
        }
        __syncthreads();
        { const int vb = wave & 3; float* Cd = CLOC + (size_t)(u0i + h) * HD * HD;
#pragma unroll
            for (int kbi = 0; kbi < 2; ++kbi) { const int kb = 2 * (wave >> 2) + kbi; f32x16 acc = {};
#pragma unroll
                for (int ts = 0; ts < 8; ++ts) { const bf16x8 A = ldfrag(VT + swz(32 * vb + r32, 2 * ts + hi)), B = ldfrag(KT + swz(32 * kb + r32, 2 * ts + hi)); acc = MFMA32(A, B, acc); }
#pragma unroll
                for (int r = 0; r < 16; ++r) Cd[(32 * vb + crow(r, hi)) * HD + 32 * kb + r32] = acc[r]; }
            if (tid < 128) NLOC[(size_t)(u0i + h) * HD + tid] = NL[tid]; }
    }
}
__device__ __forceinline__ void m2_scan(Frame& F) {
    const float* CLOC = (const float*)(F.ws + WS_CLOC); const float* NLOC = (const float*)(F.ws + WS_NLOC); const float* MLOC = (const float*)(F.ws + WS_MLOC); const float* BEND = (const float*)(F.ws + WS_BEND);
    bf16* CIN = (bf16*)(F.ws + WS_CIN); float* NIN = (float*)(F.ws + WS_NIN); float* MIN = (float*)(F.ws + WS_MIN);
    const int NGT = F.G * NWAVES * 64;
    for (int gt = F.vcu * (NWAVES * 64) + F.tid; gt < BATCH * NH * 4096; gt += NGT) {
        const int bh = gt >> 12, e4 = gt & 4095, b = bh >> 2, h = bh & 3;
        float m = 0.f; f32x4 C = {0.f, 0.f, 0.f, 0.f}, n = {0.f, 0.f, 0.f, 0.f};
        for (int c = 0; c < NCH; ++c) {
            const size_t u = (size_t)(b * NCH + c) * NH + h;
            v2u w; w.x = pk2(C.x, C.y); w.y = pk2(C.z, C.w); *(GAS v2u*)(CIN + u * HD * HD + e4 * 4) = w;
            const float mloc = MLOC[bh * NCH + c], bend = BEND[bh * NCH + c];
            const float mnew = fmaxf(bend + m, mloc), dec = __expf(bend + m - mnew), wl = __expf(mloc - mnew);
            const f32x4 cl = *(const GAS f32x4*)(CLOC + u * HD * HD + e4 * 4);
            C = C * dec + cl * wl;
            if (e4 < 32) { *(GAS f32x4*)(NIN + u * HD + e4 * 4) = n; const f32x4 nl = *(const GAS f32x4*)(NLOC + u * HD + e4 * 4); n = n * dec + nl * wl; }
            if (e4 == 0) MIN[u] = m;
            m = mnew;
        }
    }
}
__device__ __forceinline__ void m3_unit(Frame& F, int b, int c, int h) {
    lds8* lds = F.lds + RING_OFF; lds8 *XC = lds + L_XC, *XQ = lds + L_XM, *KK = lds + L_KT, *VT = lds + L_VT;
    LAS float* US = (LAS float*)(F.lds + PHM_OFF); LAS float *MT = US + 128, *BT = MT + 128, *IT = BT + 128, *NI = IT + 128, *LNS = NI + 128; volatile LAS float* WSC = (volatile LAS float*)(LNS + 512);
    int tid = F.tid; asm volatile("" : "+v"(tid));
    const int lane = tid & 63, wave = __builtin_amdgcn_readfirstlane(tid >> 6), r32 = lane & 31, hi = lane >> 5;
    const bf16* P = (const bf16*)(F.ws + WS_P); const bf16* WQKV = (const bf16*)(F.ws + WS_WQKV); bf16* Y = (bf16*)(F.ws + WS_Y);
    const size_t u = (size_t)(b * NCH + c) * NH + h; const int bh = b * NH + h;
    const bf16* CIN = (const bf16*)(F.ws + WS_CIN) + u * HD * HD;
    __syncthreads();
    stage_conv(XC, XQ, P, b, c, h, F.conv_w, F.conv_b, tid);
    if (tid < 128) { const size_t idx = (size_t)bh * SEQ + c * LCH + tid; const float min = ((const float*)(F.ws + WS_MIN))[u];
        const float uu = ((const float*)(F.ws + WS_U))[idx], cu = ((const float*)(F.ws + WS_CU))[idx], bbv = ((const float*)(F.ws + WS_BB))[idx];
        const float Mv = fmaxf(min, cu); US[tid] = uu; MT[tid] = Mv; BT[tid] = bbv; IT[tid] = __expf(min - Mv); NI[tid] = ((const float*)(F.ws + WS_NIN))[u * HD + tid]; }
    __syncthreads();
    {
        const int sb = wave & 3; const bf16* WT = WQKV + (size_t)(2 * 4 + h) * HD * HD;
#pragma unroll
        for (int vbi = 0; vbi < 2; ++vbi) { const int vb = 2 * (wave >> 2) + vbi; f32x16 acc = {};
#pragma unroll
            for (int ds = 0; ds < 8; ++ds) { const bf16x8 A = ldfrag(XQ + swz(32 * sb + r32, 2 * ds + hi)); const bf16x8 B = *(const GAS bf16x8*)(WT + (size_t)(32 * vb + r32) * HD + 16 * ds + 8 * hi); acc = MFMA32(A, B, acc); }
            store_accT(VT, acc, sb, vb, r32, hi); }
    }
    __syncthreads();
    {
        const int tb = wave & 3;
#pragma unroll
        for (int mat = 0; mat < 2; ++mat) { const bf16* WT = WQKV + (size_t)(mat * 4 + h) * HD * HD; lds8* DST = mat == 0 ? XQ : KK;
#pragma unroll
            for (int ebi = 0; ebi < 2; ++ebi) { const int eb = 2 * (wave >> 2) + ebi; f32x16 acc = {};
#pragma unroll
                for (int ds = 0; ds < 8; ++ds) { const bf16x8 A = *(const GAS bf16x8*)(WT + (size_t)(32 * eb + r32) * HD + 16 * ds + 8 * hi); const bf16x8 B = ldfrag(XC + swz(32 * tb + r32, 2 * ds + hi)); acc = MFMA32(A, B, acc); }
                if (mat == 1) {
#pragma unroll
                    for (int r = 0; r < 16; ++r) acc[r] *= KSCALE; }
                store_accT(DST, acc, eb, tb, r32, hi); } }
    }
    __syncthreads();
    const int tb = wave & 3, vh = wave >> 2, tl = 32 * tb + r32;
    bf16x8 qf[8];
#pragma unroll
    for (int es = 0; es < 8; ++es) qf[es] = ldfrag(XQ + swz(tl, 2 * es + hi));
    f32x16 o[2], cq[2];
#pragma unroll
    for (int d0 = 0; d0 < 2; ++d0) { const int vrow = 64 * vh + 32 * d0 + r32; cq[d0] = f32x16{};
#pragma unroll
        for (int ks = 0; ks < 8; ++ks) { const bf16x8 B = *(const GAS bf16x8*)(CIN + (size_t)vrow * HD + 16 * ks + 8 * hi); cq[d0] = MFMA32(qf[ks], B, cq[d0]); }
        __builtin_amdgcn_sched_barrier(0); }
    float nq = 0.f;
#pragma unroll
    for (int es = 0; es < 8; ++es)
#pragma unroll
        for (int j = 0; j < 8; ++j) nq += bf2f((bf16)qf[es][j]) * NI[16 * es + 8 * hi + j];
    nq += __shfl_xor(nq, 32);
    __builtin_amdgcn_sched_barrier(0);
    const float Mt = MT[tl];
    bf16x8 pa[4][2]; float dsum = 0.f;
#pragma unroll
    for (int sb = 0; sb < 4; ++sb) { f32x16 p = {};
        if (sb <= tb) {
#pragma unroll
            for (int es = 0; es < 8; ++es) { const bf16x8 A = ldfrag(KK + swz(32 * sb + r32, 2 * es + hi)); p = MFMA32(A, qf[es], p); }
#pragma unroll
            for (int r = 0; r < 16; ++r) { const int sl = 32 * sb + crow(r, hi); const float e = __expf(US[sl] - Mt); p[r] = (sl <= tl) ? p[r] * e : 0.f; dsum += p[r]; }
        }
        pa[sb][0] = pack8(p, 0); pa[sb][1] = pack8(p, 8);
        __builtin_amdgcn_sched_barrier(0); }
    dsum += __shfl_xor(dsum, 32);
#pragma unroll
    for (int d0 = 0; d0 < 2; ++d0) { const int vrow = 64 * vh + 32 * d0 + r32; o[d0] = f32x16{};
#pragma unroll
        for (int ks = 0; ks < 8; ++ks) { if ((ks >> 1) <= tb) { const v2u lo = *(const LAS v2u*)(VT + swz(vrow, 2 * ks) + 8 * hi), hh = *(const LAS v2u*)(VT + swz(vrow, 2 * ks + 1) + 8 * hi);
                const v4u bw = (v4u){lo.x, lo.y, hh.x, hh.y}; o[d0] = MFMA32(pa[ks >> 1][ks & 1], __builtin_bit_cast(bf16x8, bw), o[d0]); } }
        __builtin_amdgcn_sched_barrier(0); }
    const float inter = IT[tl], den = dsum + inter * nq, clampv = __expf(-(BT[tl] + Mt)), rden = 1.f / fmaxf(fabsf(den), clampv);
    volatile LAS float* wsc = WSC + wave * 64;
    if (hi == 0) { wsc[r32] = rden; wsc[32 + r32] = inter; }
    __syncthreads();
    LAS float* HT = (LAS float*)(lds + L_XM);
#pragma unroll
    for (int r = 0; r < 16; ++r) { const int tr = crow(r, hi); const float rd = wsc[tr], it = wsc[32 + tr];
#pragma unroll
        for (int d0 = 0; d0 < 2; ++d0) HT[(32 * tb + tr) * HD + 64 * vh + 32 * d0 + r32] = (o[d0][r] + it * cq[d0][r]) * rd; }
    __syncthreads();
    {
        const int tt = tid >> 2, q4 = tid & 3, col0 = h * HD + 32 * q4; const size_t row = (size_t)(b * SEQ + c * LCH + tt);
        float g[32]; float s1 = 0.f, s2 = 0.f;
#pragma unroll
        for (int i = 0; i < 4; ++i) { const v4u om = *(const GAS v4u*)(P + row * INW + C_OM + col0 + 8 * i);
#pragma unroll
            for (int j = 0; j < 2; ++j) { const f32x4 hv = *(const LAS f32x4*)(HT + tt * HD + 32 * q4 + 8 * i + 4 * j);
#pragma unroll
                for (int e = 0; e < 4; ++e) { const unsigned w = om[2 * j + (e >> 1)]; const float ov = (e & 1) ? bfhi(w) : bflo(w); const float v = hv[e] * sigmoidf_(ov); g[8 * i + 4 * j + e] = v; s1 += v; s2 += v * v; } } }
        s1 += __shfl_xor(s1, 1); s2 += __shfl_xor(s2, 1); s1 += __shfl_xor(s1, 2); s2 += __shfl_xor(s2, 2);
        const float mean = s1 * (1.f / HD), var = s2 * (1.f / HD) - mean * mean, rstd = rsqrtf(fmaxf(var, 0.f) + NORM_EPS);
#pragma unroll
        for (int i = 0; i < 4; ++i) { const v4u zm = *(const GAS v4u*)(P + row * INW + C_ZM + col0 + 8 * i); const v4u xc = *(const LAS v4u*)(XC + swz(tt, 4 * q4 + i)); float yv[8];
#pragma unroll
            for (int e = 0; e < 8; ++e) { const float zz = (e & 1) ? bfhi(zm[e >> 1]) : bflo(zm[e >> 1]), xv = (e & 1) ? bfhi(xc[e >> 1]) : bflo(xc[e >> 1]); const int col = col0 + 8 * i + e;
                yv[e] = ((g[8 * i + e] - mean) * rstd * F.mnorm_g[col] + F.skip_m[col] * xv) * siluf_(zz); }
            v4u ow; ow.x = pk2(yv[0], yv[1]); ow.y = pk2(yv[2], yv[3]); ow.z = pk2(yv[4], yv[5]); ow.w = pk2(yv[6], yv[7]);
            *(GAS v4u*)(Y + row * MIXW + col0 + 8 * i) = ow; }
    }
}
}

__device__ __forceinline__ void final_norm(Frame& F) {
    const float* ROWSS = (const float*)(F.ws + WS_ROWSS);
    const int gw = F.vcu * NWAVES + F.wave, NGW = F.G * NWAVES;
    f32x4 gv[4];
#pragma unroll
    for (int j = 0; j < 4; ++j) gv[j] = *((const GAS f32x4*)F.final_g + F.lane + 64 * j);
    for (int m = gw; m < M; m += NGW) { const float rstd = rsqrtf(ROWSS[m] * (1.f / DM) + NORM_EPS); GAS f32x4* o = (GAS f32x4*)(F.out + (size_t)m * DM) + F.lane;
#pragma unroll
        for (int j = 0; j < 4; ++j) o[64 * j] = o[64 * j] * rstd * gv[j]; }
}

struct Args { const float* in[22]; float* out; unsigned char* ws; int ph_lo, ph_hi, li, pad; };
__global__ void __launch_bounds__(NWAVES * 64, 2) hybrid_fwd(Args args) {
    extern __shared__ __attribute__((aligned(16))) unsigned char lds[];
    Frame F;
    F.lds = (lds8*)lds;
    F.MISC = (volatile LAS unsigned*)(F.lds + MISC_OFF);
    F.tid = threadIdx.x; F.lane = F.tid & 63; F.wave = __builtin_amdgcn_readfirstlane(F.tid >> 6);
    F.G = gridDim.x; { const int bx = blockIdx.x; F.vcu = (F.G % 8 == 0) ? (bx % 8) * (F.G / 8) + bx / 8 : bx; }
    F.ws = args.ws; F.out = args.out; F.ctl = (gu32*)(args.ws + WS_CTL);
    F.x = args.in[0]; F.mem = args.in[1]; F.norm_g = args.in[2]; F.w_in = args.in[3]; F.conv_w = args.in[4]; F.conv_b = args.in[5]; F.wq_m = args.in[6]; F.wk_m = args.in[7]; F.wv_m = args.in[8];
    F.w_if = args.in[9]; F.b_if = args.in[10]; F.mnorm_g = args.in[11]; F.skip_m = args.in[12]; F.lam_q1 = args.in[13]; F.lam_k1 = args.in[14]; F.lam_q2 = args.in[15]; F.lam_k2 = args.in[16];
    F.dnorm_g = args.in[17]; F.mem_norm_g = args.in[18]; F.w_mem_kv = args.in[19]; F.w_out = args.in[20]; F.final_g = args.in[21];
    for (int u = F.tid; u < (LDS_BYTES - LDSCTL_OFF) / 4; u += NWAVES * 64) ((LAS unsigned*)(F.lds + LDSCTL_OFF))[u] = 0u;
    __syncthreads();
    XcdBarrier bar; bar.bar = (unsigned*)(F.ctl + CW_BAR); bar.x = 0; bar.st = nullptr;
    if (MK_N_LAUNCHES == 1) bar = xcd_barrier_post((unsigned*)(F.ctl + CW_BAR), F.MISC + 8);
    const int lo = args.ph_lo, hi = args.ph_hi;
#define IN(k) (lo <= (k) && (k) < hi)
#define SEAM(k) do { if (IN(k) && IN((k) + 1)) xcd_barrier(bar); } while (0)

    if (IN(0)) { p0_prologue(F); }
    SEAM(0);
    if (IN(1)) {
        { pg8::Gemm g{(const bf16*)(F.ws + WS_H), (const bf16*)(F.ws + WS_WIN), M, INW, DM}; pg8::StaticOrder S; S.init(M, INW, F.G, (int)blockIdx.x);
          pg8::EpiBf16<0> E{(bf16*)(F.ws + WS_P), INW, nullptr, 0, 0, 1.f};
          pg8::gemm_phase<pg8::EpiBf16<0>, pg8::StaticOrder, PG8_ALIGN, PG8_SP2>(F.lds + RING_OFF, g, S, E); }
        { pg8::Gemm g{(const bf16*)(F.ws + WS_MEMN), (const bf16*)(F.ws + WS_WMEM), MEMROWS, DM, DM}; pg8::StaticOrder S; S.init(MEMROWS, DM, F.G, (int)blockIdx.x);
          pg8::EpiBf16<0> E{(bf16*)(F.ws + WS_MEMKV), DM, nullptr, 0, 0, 1.f};
          pg8::gemm_phase<pg8::EpiBf16<0>, pg8::StaticOrder, PG8_ALIGN, PG8_SP2>(F.lds + RING_OFF, g, S, E); }
    }
    SEAM(1);
    if (IN(2)) {
#if EN_MLSTM && !defined(NO_M1)
        for (int u = F.vcu; u < BATCH * NCH; u += F.G) ml::m1_unit(F, u / NCH, u % NCH);
#endif
#if EN_CROSS
        for (int u = F.vcu; u < BATCH * NH * (SEQ / 256); u += F.G) { const int bh = u / (SEQ / 256); att::cross_unit(F, bh >> 2, bh & 3, u % (SEQ / 256)); }
#endif
#if EN_DIFF
        { float s1 = 0.f, s2 = 0.f; for (int i = 0; i < 64; ++i) { s1 += F.lam_q1[i] * F.lam_k1[i]; s2 += F.lam_q2[i] * F.lam_k2[i]; }
          const float lam = expf(s1) - expf(s2) + 0.2f;
          for (int pid = F.vcu; pid < BATCH * NH * 16; pid += F.G) { const int bh = pid >> 4, j = pid & 15; att::diff_unit(F, bh >> 2, bh & 3, 31 - j, lam); att::diff_unit(F, bh >> 2, bh & 3, j, lam); } }
#endif
    }
    SEAM(2);
    if (IN(3)) {
#if EN_MLSTM
        ml::m2_scan(F);
#endif
    }
    SEAM(3);
    if (IN(4)) {
#if EN_MLSTM && !defined(NO_M3)
        for (int u = F.vcu; u < BATCH * NCH * NH; u += F.G) ml::m3_unit(F, u / (NCH * NH), (u / NH) % NCH, u % NH);
#endif
    }
    SEAM(4);
    if (IN(5)) {
        pg8::Gemm g{(const bf16*)(F.ws + WS_Y), (const bf16*)(F.ws + WS_WOUT), M, DM, MIXW}; pg8::StaticOrder S; S.init(M, DM, F.G, (int)blockIdx.x);
        pg8::EpiResSS E{F.x, F.out, DM, (float*)(F.ws + WS_ROWSS)};
        pg8::gemm_phase<pg8::EpiResSS, pg8::StaticOrder, PG8_ALIGN, PG8_SP2>(F.lds + RING_OFF, g, S, E);
    }
    SEAM(5);
    if (IN(6)) final_norm(F);
#undef IN
#undef SEAM
}

extern "C" void kernel_launch(void* const* d_in, const int* in_sizes, int n_in, void* d_out, int out_size, void* d_ws, size_t ws_size, hipStream_t stream) {
    static int grid = 0;
    if (grid == 0) {
        if (n_in != 22 || in_sizes[0] != M * DM || out_size != M * DM || ws_size < WS_END) { fprintf(stderr, "kernel_launch: unexpected shapes (n_in %d in0 %d out %d ws %zu); nothing launched\n", n_in, n_in > 0 ? in_sizes[0] : -1, out_size, ws_size); grid = -1; return; }
        int dev = 0, cus = 0, per_cu = 0;
        if (hipGetDevice(&dev) != hipSuccess || hipDeviceGetAttribute(&cus, hipDeviceAttributeMultiprocessorCount, dev) != hipSuccess) { grid = -1; return; }
        if (hipFuncSetAttribute((const void*)hybrid_fwd, hipFuncAttributeMaxDynamicSharedMemorySize, LDS_BYTES) != hipSuccess) { fprintf(stderr, "kernel_launch: hipFuncSetAttribute failed\n"); grid = -1; return; }
        if (hipOccupancyMaxActiveBlocksPerMultiprocessor(&per_cu, (const void*)hybrid_fwd, NWAVES * 64, LDS_BYTES) != hipSuccess || per_cu < 1) { fprintf(stderr, "kernel_launch: occupancy query reports %d workgroups per CU\n", per_cu); (void)hipGetLastError(); grid = -1; return; }
        grid = cus;
    }
    if (grid < 0) return;
    (void)hipMemsetAsync((char*)d_ws + WS_CTL, 0, CTL_ZERO_BYTES, stream);
    Args a{};
    for (int i = 0; i < 22; ++i) a.in[i] = (const float*)d_in[i];
    a.out = (float*)d_out; a.ws = (unsigned char*)d_ws;
    if (MK_N_LAUNCHES == 1) { a.ph_lo = 0; a.ph_hi = N_PHASES; a.li = 0; hipLaunchKernelGGL(hybrid_fwd, dim3(grid), dim3(NWAVES * 64), LDS_BYTES, stream, a); }
    else for (int li = 0; li < N_PHASES; ++li) { a.ph_lo = li; a.ph_hi = li + 1; a.li = li; hipLaunchKernelGGL(hybrid_fwd, dim3(grid), dim3(NWAVES * 64), LDS_BYTES, stream, a); }
}
```

```cpp
#include <hip/hip_runtime.h>
#include <hip/hip_bf16.h>
#include <cstdio>
#include <cstdint>
#include <cmath>
namespace pg8 {
#define PG8_LAS __attribute__((address_space(3)))
typedef unsigned short bf16_t;
typedef short bf16x8 __attribute__((ext_vector_type(8)));
typedef float f32x4 __attribute__((ext_vector_type(4)));
typedef unsigned u32x4 __attribute__((ext_vector_type(4)));
constexpr int BM = 256, BK = 64, HALF = 128, HTB = HALF * BK * 2  , STAGE_BYTES = 8 * HTB, NXCD = 8, WGM = 8;

__host__ __device__ __forceinline__ int lds_byte(int r, int c) { const int st = (r >> 4) * 2 + (c >> 5), rr = r & 15, cc = c & 31, ob = rr * 64 + cc * 2; return st * 1024 + (ob ^ (((ob >> 9) & 1) << 5)); }
__host__ __device__ __forceinline__ void stage_rc(int b, int& R, int& C) { const int st = b / 1024, sb = b % 1024, swz = sb ^ (((sb >> 9) & 1) << 5); R = (st >> 1) * 16 + swz / 64; C = (st & 1) * 32 + (swz % 64) / 2; }
__host__ __device__ __forceinline__ int perm32(int rho) { const int n = rho >> 4, i = rho & 15; return 8 * (i >> 2) + 4 * n + (i & 3); }

struct Unit { int pm, pn; };
struct Gemm { const bf16_t* A; const bf16_t* Bt; int M, N, K; };

struct StaticOrder {
    int nM, nN, nwg, G, c;
    __host__ __device__ void init(int M, int N, int G_, int c_) { nM = M / BM; nN = N / BM; nwg = nM * nN; G = G_; c = c_; }
    __host__ __device__ bool next(int i, Unit& u) const {
        const long L = (long)i * G + c; if (L >= nwg) return false;
        int wgid = (int)L; { const int q = nwg / NXCD, r = nwg % NXCD, xcd = wgid % NXCD, off = wgid / NXCD; wgid = (xcd < r ? xcd * (q + 1) : r * (q + 1) + (xcd - r) * q) + off; }
        const int nig = WGM * nN, gid = wgid / nig, fm = gid * WGM, gsz = (nM - fm) < WGM ? (nM - fm) : WGM;
        u.pm = fm + ((wgid % nig) % gsz); u.pn = (wgid % nig) / gsz; return true;
    }
    __device__ __forceinline__ void a_ready(const Unit&) const {}
    __device__ __forceinline__ void done(const Unit&) const {}
};

__device__ __forceinline__ unsigned cvt_pk_bf16(float lo, float hi) { unsigned r; asm volatile("v_cvt_pk_bf16_f32 %0, %1, %2" : "=v"(r) : "v"(lo), "v"(hi)); return r; }
typedef float f32x2 __attribute__((ext_vector_type(2)));
__device__ __forceinline__ f32x2 gelu_pk(f32x2 v) {
    const f32x2 av = __builtin_elementwise_abs(v), d = av * 0.2316418882f + 1.0f;
    f32x2 t; t.x = __builtin_amdgcn_rcpf(d.x); t.y = __builtin_amdgcn_rcpf(d.y);
    f32x2 q = t * 0.5307027145f + (-0.7265760135f); q = q * t + 0.7107068705f; q = q * t + (-0.142248368f); q = q * t + 0.127414796f; q = q * t;
    const f32x2 s = (v * v) * (-0.72134752044f);
    f32x2 e; e.x = __builtin_amdgcn_exp2f(s.x); e.y = __builtin_amdgcn_exp2f(s.y);
    const f32x2 m = v * (q * e), r = v - m;
    f32x2 o; o.x = v.x < 0.f ? m.x : r.x; o.y = v.y < 0.f ? m.y : r.y; return o;
}

template <int ACT  > struct EpiBf16 {
    static constexpr bool PERM = true, AFTER_DRAIN = false; static_assert(ACT == 0 || ACT == 1, "EpiBf16: ACT is 0 (none) or 1 (gelu_pk)");
    bf16_t* O; int ldc; const float* bias; int split_cols; size_t split_stride; float scale0;
    __device__ __forceinline__ void operator()(const f32x4 (&acc)[2][2][4][2], const Unit& u, int wr, int wc, int fr, int fq) const {
        const int row0 = u.pm * BM + wr * 64 + fr; int colt = u.pn * BM; bf16_t* base = O;
        float sc = 1.f; if (split_cols) { const int t = colt / split_cols; base += (size_t)t * split_stride; colt -= t * split_cols; if (t == 0) sc = scale0; }
        const int col0 = colt + wc * 32 + 8 * fq, bcol0 = u.pn * BM + wc * 32 + 8 * fq;
        f32x4 bv[2][2];
#pragma unroll
        for (int bj = 0; bj < 2; ++bj)
#pragma unroll
            for (int n = 0; n < 2; ++n) bv[bj][n] = bias ? *(const f32x4*)(bias + bcol0 + bj * HALF + 4 * n) : (f32x4){0.f, 0.f, 0.f, 0.f};
#pragma unroll
        for (int ai = 0; ai < 2; ++ai)
#pragma unroll
            for (int m = 0; m < 4; ++m) { bf16_t* rowp = base + (size_t)(row0 + ai * HALF + m * 16) * ldc + col0;
#pragma unroll
                for (int bj = 0; bj < 2; ++bj) { f32x4 v0 = acc[ai][bj][m][0] + bv[bj][0], v1 = acc[ai][bj][m][1] + bv[bj][1];
                    if (ACT == 1) { f32x2 a = gelu_pk((f32x2){v0[0], v0[1]}), b = gelu_pk((f32x2){v0[2], v0[3]}), c = gelu_pk((f32x2){v1[0], v1[1]}), d = gelu_pk((f32x2){v1[2], v1[3]});
                        v0 = (f32x4){a.x, a.y, b.x, b.y}; v1 = (f32x4){c.x, c.y, d.x, d.y}; }
                    v0 = v0 * sc; v1 = v1 * sc; u32x4 w; w.x = cvt_pk_bf16(v0[0], v0[1]); w.y = cvt_pk_bf16(v0[2], v0[3]); w.z = cvt_pk_bf16(v1[0], v1[1]); w.w = cvt_pk_bf16(v1[2], v1[3]);
                    *(u32x4*)(rowp + bj * HALF) = w; } }
    }
};
struct EpiResSS {
    static constexpr bool PERM = false, AFTER_DRAIN = false;
    const float* base; float* out; int ldc; float* rowss;
    __device__ __forceinline__ void operator()(const f32x4 (&acc)[2][2][4][2], const Unit& u, int wr, int wc, int fr, int fq) const {
        const int row0 = u.pm * BM + wr * 64 + fr, col0 = u.pn * BM + wc * 32 + 4 * fq;
#pragma unroll
        for (int ai = 0; ai < 2; ++ai)
#pragma unroll
            for (int m = 0; m < 4; ++m) { const int row = row0 + ai * HALF + m * 16; const size_t off = (size_t)row * ldc + col0; float ss = 0.f;
#pragma unroll
                for (int bj = 0; bj < 2; ++bj)
#pragma unroll
                    for (int n = 0; n < 2; ++n) { const f32x4 b = *(const f32x4*)(base + off + bj * HALF + n * 16); const f32x4 v = acc[ai][bj][m][n] + b;
                        ss += (v[0] * v[0] + v[1] * v[1]) + (v[2] * v[2] + v[3] * v[3]); *(f32x4*)(out + off + bj * HALF + n * 16) = v; }
                ss += __shfl_xor(ss, 16); ss += __shfl_xor(ss, 32);
                if (fq == 0) atomicAdd(rowss + row, ss); }
    }
};
struct EpiBf16Q {
    static constexpr bool PERM = true, AFTER_DRAIN = false;
    bf16_t* O; int mrows; float sc6, sc14;
    __device__ __forceinline__ void operator()(const f32x4 (&acc)[2][2][4][2], const Unit& u, int wr, int wc, int fr, int fq) const {
        const int row0 = u.pm * BM + wr * 64 + fr, col0 = wc * 32 + 8 * fq;
        const float sc = (u.pn == 6 || u.pn == 7) ? sc6 : ((u.pn == 14 || u.pn == 15) ? sc14 : 1.f);
#pragma unroll
        for (int ai = 0; ai < 2; ++ai)
#pragma unroll
            for (int m = 0; m < 4; ++m) { const size_t row = (size_t)(row0 + ai * HALF + m * 16);
#pragma unroll
                for (int bj = 0; bj < 2; ++bj) { const f32x4 v0 = acc[ai][bj][m][0] * sc, v1 = acc[ai][bj][m][1] * sc;
                    u32x4 w; w.x = cvt_pk_bf16(v0[0], v0[1]); w.y = cvt_pk_bf16(v0[2], v0[3]); w.z = cvt_pk_bf16(v1[0], v1[1]); w.w = cvt_pk_bf16(v1[2], v1[3]);
                    *(u32x4*)(O + ((size_t)(2 * u.pn + bj) * mrows + row) * 128 + col0) = w; } }
    }
};
template <class Epi, class Sched, bool ALIGN_EPI = false, bool SP2 = false>
__device__ __forceinline__ void gemm_phase(PG8_LAS unsigned char* lds, const Gemm g, const Sched& S, const Epi& E) {
    const int tid = threadIdx.x, wid = __builtin_amdgcn_readfirstlane(tid >> 6), lane = tid & 63, wr = wid >> 2, wc = wid & 3, fr = lane & 15, fq = lane >> 4;
    const int K = g.K, nt = K / BK;
    unsigned voffA[2], voffB[2];
#pragma unroll
    for (int i = 0; i < 2; ++i) { int R, C; stage_rc(tid * 16 + i * 8192, R, C); const int Rb = Epi::PERM ? ((R & ~31) + perm32(R & 31)) : R;
        voffA[i] = (unsigned)(R * K + C) * 2u; voffB[i] = (unsigned)(Rb * K + C) * 2u; }
    const size_t kstep = (size_t)(BK * 2);
    const size_t hstep = (size_t)HALF * K * 2;
    const size_t tstep = 2 * hstep;
    const unsigned ldsw = (unsigned)wid * 1024u;
    const int aoff = lds_byte(wr * 64 + fr, fq * 8), boff = lds_byte(wc * 32 + fr, fq * 8);
#define PG8_SA(b, h) (((b) * 2 + (h)) * HTB)
#define PG8_SB(b, h) ((4 + (b) * 2 + (h)) * HTB)
#define PG8_STAGE(bufoff, gbase, voff) do { _Pragma("unroll") for (int _i = 0; _i < 2; ++_i) \
        __builtin_amdgcn_global_load_lds((const unsigned*)((const char*)(gbase) + (voff)[_i]), (PG8_LAS unsigned*)(lds + (bufoff) + ldsw + _i * 8192), 16, 0, 0); } while (0)
#define PG8_LDA(dst, b, h) do { _Pragma("unroll") for (int m = 0; m < 4; ++m) _Pragma("unroll") for (int k = 0; k < 2; ++k) dst[m][k] = *(const PG8_LAS bf16x8*)(lds + PG8_SA(b, h) + aoff + m * 2048 + k * 1024); } while (0)
#define PG8_LDB(dst, b, h) do { _Pragma("unroll") for (int n = 0; n < 2; ++n) _Pragma("unroll") for (int k = 0; k < 2; ++k) dst[n][k] = *(const PG8_LAS bf16x8*)(lds + PG8_SB(b, h) + boff + n * 2048 + k * 1024); } while (0)
#define PG8_MMA(ai, bj, At, Bt) do { __builtin_amdgcn_s_setprio(1); _Pragma("unroll") for (int m = 0; m < 4; ++m) _Pragma("unroll") for (int n = 0; n < 2; ++n) _Pragma("unroll") for (int k = 0; k < 2; ++k) \
        acc[ai][bj][m][n] = __builtin_amdgcn_mfma_f32_16x16x32_bf16(Bt[n][k], At[m][k], acc[ai][bj][m][n], 0, 0, 0); __builtin_amdgcn_s_setprio(0); } while (0)
#define PG8_WAIT_V(n) asm volatile("s_waitcnt vmcnt(" #n ")" ::: "memory")
#define PG8_WAIT_L(n) asm volatile("s_waitcnt lgkmcnt(" #n ")" ::: "memory")
#define PG8_BAR __builtin_amdgcn_s_barrier()
#define PG8_SCHED __builtin_amdgcn_sched_barrier(0)
    Unit cur, nxt; int ui = 0;
    if (!S.next(0, cur)) return;
    f32x4 acc[2][2][4][2];
#pragma unroll
    for (int a = 0; a < 2; ++a)
#pragma unroll
        for (int b = 0; b < 2; ++b)
#pragma unroll
            for (int m = 0; m < 4; ++m)
#pragma unroll
                for (int n = 0; n < 2; ++n) acc[a][b][m][n] = (f32x4){0.f, 0.f, 0.f, 0.f};
    bf16x8 At[4][2], B0[2][2], B1[2][2];
    const char* cA = (const char*)g.A + (size_t)cur.pm * tstep; const char* cB = (const char*)g.Bt + (size_t)cur.pn * tstep;
    S.a_ready(cur);
    if constexpr (SP2) {
        PG8_STAGE(PG8_SB(0, 0), cB, voffB); PG8_STAGE(PG8_SB(0, 1), cB + hstep, voffB); PG8_STAGE(PG8_SA(0, 0), cA, voffA); PG8_STAGE(PG8_SA(0, 1), cA + hstep, voffA);
        if (wr == 1) PG8_BAR;
        PG8_WAIT_V(2); PG8_BAR;
        PG8_STAGE(PG8_SB(1, 0), cB + kstep, voffB); PG8_STAGE(PG8_SA(1, 0), cA + kstep, voffA); PG8_STAGE(PG8_SB(1, 1), cB + hstep + kstep, voffB);
        PG8_WAIT_V(6); PG8_BAR;
    } else {
        PG8_STAGE(PG8_SB(0, 0), cB, voffB); PG8_STAGE(PG8_SA(0, 0), cA, voffA); PG8_STAGE(PG8_SB(0, 1), cB + hstep, voffB); PG8_STAGE(PG8_SA(0, 1), cA + hstep, voffA);
        if (wr == 1) PG8_BAR;
        PG8_WAIT_V(4); PG8_BAR;
        PG8_STAGE(PG8_SB(1, 0), cB + kstep, voffB); PG8_STAGE(PG8_SA(1, 0), cA + kstep, voffA); PG8_STAGE(PG8_SB(1, 1), cB + hstep + kstep, voffB);
        PG8_WAIT_V(6); PG8_BAR;
    }
    for (;;) {
        const bool has_next = S.next(ui + 1, nxt);
        const char* nA = has_next ? (const char*)g.A + (size_t)nxt.pm * tstep : cA; const char* nB = has_next ? (const char*)g.Bt + (size_t)nxt.pn * tstep : cB;
        for (int t = 0; t < nt; t += 2) {
            const bool last = (t == nt - 2);
            const char* a1 = cA + (size_t)(t + 1) * kstep;
            const char* a2 = last ? nA : cA + (size_t)(t + 2) * kstep; const char* b2 = last ? nB : cB + (size_t)(t + 2) * kstep;
            const char* a3 = a2 + kstep; const char* b3 = b2 + kstep;
            if (last && has_next) S.a_ready(nxt);
            if constexpr (SP2) {
            PG8_LDB(B0, 0, 0); PG8_LDB(B1, 0, 1); PG8_SCHED; PG8_LDA(At, 0, 0); PG8_STAGE(PG8_SA(1, 1), a1 + hstep, voffA);
            PG8_WAIT_V(8); PG8_WAIT_L(0); PG8_BAR; PG8_MMA(0, 0, At, B0); PG8_MMA(0, 1, At, B1); PG8_BAR; PG8_SCHED;
            PG8_LDA(At, 0, 1); PG8_STAGE(PG8_SB(0, 0), b2, voffB); PG8_STAGE(PG8_SB(0, 1), b2 + hstep, voffB); PG8_STAGE(PG8_SA(0, 0), a2, voffA);
            PG8_WAIT_V(8); PG8_WAIT_L(0); PG8_BAR; PG8_MMA(1, 0, At, B0); PG8_MMA(1, 1, At, B1); PG8_BAR; PG8_SCHED;
            PG8_LDB(B0, 1, 0); PG8_LDB(B1, 1, 1); PG8_SCHED; PG8_LDA(At, 1, 0); PG8_STAGE(PG8_SA(0, 1), a2 + hstep, voffA);
            PG8_WAIT_V(8); PG8_WAIT_L(0); PG8_BAR; PG8_MMA(0, 0, At, B0); PG8_MMA(0, 1, At, B1); PG8_BAR; PG8_SCHED;
            PG8_LDA(At, 1, 1); PG8_STAGE(PG8_SB(1, 0), b3, voffB); PG8_STAGE(PG8_SB(1, 1), b3 + hstep, voffB); PG8_STAGE(PG8_SA(1, 0), a3, voffA);
            PG8_WAIT_V(8); PG8_WAIT_L(0); PG8_BAR; PG8_MMA(1, 0, At, B0); PG8_MMA(1, 1, At, B1); PG8_BAR; PG8_SCHED;
            } else {
            PG8_LDB(B0, 0, 0); PG8_SCHED; PG8_LDA(At, 0, 0); PG8_STAGE(PG8_SA(1, 1), a1 + hstep, voffA);
            PG8_WAIT_L(8); PG8_BAR; PG8_WAIT_L(0); PG8_MMA(0, 0, At, B0); PG8_BAR; PG8_SCHED;
            PG8_LDB(B1, 0, 1); PG8_STAGE(PG8_SB(0, 0), b2, voffB);
            PG8_BAR; PG8_WAIT_L(0); PG8_MMA(0, 1, At, B1); PG8_BAR;
            PG8_LDA(At, 0, 1); PG8_STAGE(PG8_SA(0, 0), a2, voffA);
            PG8_BAR; PG8_WAIT_L(0); PG8_MMA(1, 0, At, B0); PG8_BAR; PG8_SCHED;
            PG8_STAGE(PG8_SB(0, 1), b2 + hstep, voffB);
            PG8_WAIT_V(6); PG8_BAR; PG8_MMA(1, 1, At, B1); PG8_BAR;
            PG8_LDB(B0, 1, 0); PG8_SCHED; PG8_LDA(At, 1, 0); PG8_STAGE(PG8_SA(0, 1), a2 + hstep, voffA);
            PG8_WAIT_L(8); PG8_BAR; PG8_WAIT_L(0); PG8_MMA(0, 0, At, B0); PG8_BAR; PG8_SCHED;
            PG8_LDB(B1, 1, 1); PG8_STAGE(PG8_SB(1, 0), b3, voffB);
            PG8_BAR; PG8_WAIT_L(0); PG8_MMA(0, 1, At, B1); PG8_BAR;
            PG8_LDA(At, 1, 1); PG8_STAGE(PG8_SA(1, 0), a3, voffA);
            PG8_BAR; PG8_WAIT_L(0); PG8_MMA(1, 0, At, B0); PG8_BAR; PG8_SCHED;
            PG8_STAGE(PG8_SB(1, 1), b3 + hstep, voffB);
            PG8_WAIT_V(6); PG8_BAR; PG8_MMA(1, 1, At, B1); PG8_BAR;
            }
        }
        if constexpr (ALIGN_EPI) { if (wr == 0) PG8_BAR; }
        if constexpr (!Epi::AFTER_DRAIN) { E(acc, cur, wr, wc, fr, fq); S.done(cur); }
        if (!has_next) break;
#pragma unroll
        for (int a = 0; a < 2; ++a)
#pragma unroll
            for (int b = 0; b < 2; ++b)
#pragma unroll
                for (int m = 0; m < 4; ++m)
#pragma unroll
                    for (int n = 0; n < 2; ++n) acc[a][b][m][n] = (f32x4){0.f, 0.f, 0.f, 0.f};
        cur = nxt; cA = nA; cB = nB; ++ui;
        if constexpr (ALIGN_EPI) { if (wr == 1) PG8_BAR; }
    }
    PG8_WAIT_V(0);
    if constexpr (!ALIGN_EPI) { if (wr == 0) PG8_BAR; }
    PG8_BAR;
    if constexpr (Epi::AFTER_DRAIN) { E.fused(acc, cur, wr, wc, fr, fq, lds, wid, lane); S.done(cur); }
#undef PG8_SA
#undef PG8_SB
#undef PG8_STAGE
#undef PG8_LDA
#undef PG8_LDB
#undef PG8_MMA
#undef PG8_WAIT_V
#undef PG8_WAIT_L
#undef PG8_BAR
#undef PG8_SCHED
}
}

#ifndef PG8_SP2
#define PG8_SP2 true
#endif
#ifndef PG8_ALIGN
#define PG8_ALIGN true
#endif
constexpr int NWAVES = 8;
#ifndef MK_N_LAUNCHES
#define MK_N_LAUNCHES 1
#endif
#ifndef EN_CROSS
#define EN_CROSS 1
#endif
#ifndef EN_DIFF
#define EN_DIFF 1
#endif
#ifndef EN_MLSTM
#define EN_MLSTM 1
#endif
constexpr int N_PHASES = 7;

constexpr int BATCH = 8, SEQ = 4096, DM = 1024, M = BATCH * SEQ, INW = 4608, MIXW = 1536, MEML = 256, MEMROWS = BATCH * MEML;
constexpr int NH = 4, HD = 128, LCH = 128, NCH = SEQ / LCH;
constexpr int G_XM = 0, G_OM = 4, G_ZM = 8, G_QD = 12, G_KD = 16, G_VD = 20, G_ZD = 24, G_QC = 28, G_ZC = 32;
constexpr int PP = 128;
#define PGRP(P, g) ((P) + (size_t)(g) * M * PP)
constexpr float NORM_EPS = 1e-6f;

constexpr size_t KiB = 1024, MiB = 1u << 20;
constexpr size_t WS_CTL = 0, CTL_ZERO_BYTES = 1 * MiB;
constexpr size_t WS_ROWSS = 1 * MiB;
constexpr size_t WS_WG = 1 * MiB + 128 * KiB;
constexpr size_t WS_MLOC = 1 * MiB + 192 * KiB, WS_BEND = WS_MLOC + 4 * KiB, WS_MIN = WS_MLOC + 8 * KiB;
constexpr size_t WS_NLOC = 2 * MiB, WS_NIN = 2 * MiB + 512 * KiB;
constexpr size_t WS_BB = 3 * MiB, WS_U = 3 * MiB + 512 * KiB, WS_CU = 4 * MiB;
constexpr size_t WS_WQKV = 5 * MiB;
constexpr size_t WS_WIN = 6 * MiB;
constexpr size_t WS_WOUT = 15 * MiB;
constexpr size_t WS_WMEM = 18 * MiB;
constexpr size_t WS_MEMN = 20 * MiB;
constexpr size_t WS_MEMKV = 24 * MiB;
constexpr size_t WS_CIN = 32 * MiB;
constexpr size_t WS_H = 64 * MiB;
constexpr size_t WS_CLOC = WS_H;
constexpr size_t WS_P = 128 * MiB;
constexpr size_t WS_Y = 416 * MiB;
constexpr size_t WS_END = 512 * MiB;
static_assert(WS_P + (size_t)M * INW * 2 == WS_Y && WS_Y + (size_t)M * MIXW * 2 == WS_END, "ws map");
constexpr int CW_TMO = 0, CW_CODE = 1, CW_BAR = 4096;

constexpr int RING_OFF = 0, RING_BYTES = 131072;
constexpr int PHM_OFF = RING_BYTES;
constexpr int LDS_BYTES = 147456;
constexpr int LDSCTL_OFF = LDS_BYTES - 512, MISC_OFF = LDSCTL_OFF;

#define GAS __attribute__((address_space(1)))
#define LAS __attribute__((address_space(3)))
typedef unsigned short bf16;
typedef unsigned v4u __attribute__((ext_vector_type(4)));
typedef unsigned v2u __attribute__((ext_vector_type(2)));
typedef float f32x4 __attribute__((ext_vector_type(4)));
typedef float f32x2 __attribute__((ext_vector_type(2)));
typedef float f32x16 __attribute__((ext_vector_type(16)));
typedef short bf16x8 __attribute__((ext_vector_type(8)));
typedef short s16x4 __attribute__((ext_vector_type(4)));
typedef __bf16 bf16x2_t __attribute__((ext_vector_type(2)));
typedef GAS unsigned gu32;
typedef GAS unsigned long long gu64;
typedef LAS unsigned char lds8;
#define RLX_AGENT __ATOMIC_RELAXED, __HIP_MEMORY_SCOPE_AGENT
#define LDS_WAIT() asm volatile("s_waitcnt lgkmcnt(0)" ::: "memory")
#define VM_WAIT() asm volatile("s_waitcnt vmcnt(0)" ::: "memory")
#define MFMA32(a, b, c) __builtin_amdgcn_mfma_f32_32x32x16_bf16(a, b, c, 0, 0, 0)
__device__ __forceinline__ unsigned pk2(float lo, float hi) { f32x2 v = {lo, hi}; bf16x2_t b = __builtin_convertvector(v, bf16x2_t); return __builtin_bit_cast(unsigned, b); }
__device__ __forceinline__ float bflo(unsigned w) { return __uint_as_float(w << 16); }
__device__ __forceinline__ float bfhi(unsigned w) { return __uint_as_float(w & 0xffff0000u); }
__device__ __forceinline__ float bf2f(bf16 b) { return __uint_as_float((unsigned)b << 16); }
__device__ __forceinline__ bf16 f2bf(float f) { return (bf16)(pk2(f, 0.f) & 0xffffu); }
__device__ __forceinline__ int crow(int r, int hi) { return (r & 3) + 8 * (r >> 2) + 4 * hi; }
__device__ __forceinline__ float sigmoidf_(float x) { return __builtin_amdgcn_rcpf(1.f + __expf(-x)); }
__device__ __forceinline__ float siluf_(float x) { return x * __builtin_amdgcn_rcpf(1.f + __expf(-x)); }
__device__ __forceinline__ int swz(int row, int chunk) { return row * 256 + ((chunk ^ (row & 15)) << 4); }
__device__ __forceinline__ bf16x8 ldfrag(const lds8* p) { return *(const LAS bf16x8*)p; }
__device__ __forceinline__ bf16x8 pack8(const f32x16& p, int b) { v4u w; w.x = pk2(p[b], p[b + 1]); w.y = pk2(p[b + 2], p[b + 3]); w.z = pk2(p[b + 4], p[b + 5]); w.w = pk2(p[b + 6], p[b + 7]); return __builtin_bit_cast(bf16x8, w); }
typedef short v4i16_t __attribute__((ext_vector_type(4)));
__device__ __forceinline__ s16x4 vtr(const lds8* p) { return __builtin_bit_cast(s16x4, __builtin_amdgcn_ds_read_tr16_b64_v4i16((LAS v4i16_t*)p)); }
#define XB_TMO      128
#define XB_XCNT(j)  (256  + 64 * (j))
#define XB_XSUB(j)  (1280 + 64 * (j))
#define XB_XGEN(j)  (2304 + 64 * (j))
#define XB_TOP      3328
#define XB_TOPGEN   3392
#define XCD_BAR_WORDS 3456
#define XB_SPIN_CAP (1u << 18)

__device__ __forceinline__ unsigned xb_ld(unsigned* p)              { return __hip_atomic_load(p, __ATOMIC_RELAXED, __HIP_MEMORY_SCOPE_AGENT); }
__device__ __forceinline__ unsigned xb_add(unsigned* p, unsigned v) { return __hip_atomic_fetch_add(p, v, __ATOMIC_RELAXED, __HIP_MEMORY_SCOPE_AGENT); }
__device__ __forceinline__ unsigned xb_xcc_id() { return (unsigned)__builtin_amdgcn_s_getreg((3 << 11) | 20) & 0xFu; }
#define XB_SPIN(cond, bar) do { unsigned _sp = 0; while (cond) { __builtin_amdgcn_s_sleep(1); \
    if ((++_sp & 255u) == 0u) { if (xb_ld(&(bar)[XB_TMO])) break; if (_sp > XB_SPIN_CAP) { atomicAdd(&(bar)[XB_TMO], 1u); break; } } } } while (0)

struct XcdBarrier {
    unsigned* bar; unsigned x;
    volatile LAS unsigned* st;
};

__device__ __forceinline__ XcdBarrier xcd_barrier_post(unsigned* bar, volatile LAS unsigned* st) {
    XcdBarrier b; b.bar = bar; b.x = xb_xcc_id(); b.st = st;
    if (threadIdx.x == 0) (void)xb_add(&bar[XB_XCNT(b.x)], 1u);
    return b;
}
__device__ __forceinline__ void xcd_barrier_complete(unsigned* bar, unsigned x, unsigned& nloc, unsigned& nx) {
    const unsigned G = gridDim.x * gridDim.y * gridDim.z;
    unsigned sum, cnt, mine, sp = 0u;
    for (;;) {
        sum = 0u; cnt = 0u; mine = 0u;
#pragma unroll
        for (unsigned j = 0; j < 16; ++j) { const unsigned c = xb_ld(&bar[XB_XCNT(j)]); sum += c; cnt += (c > 0u) ? 1u : 0u; mine = (j == x) ? c : mine; }
        if (sum == G) break;
        __builtin_amdgcn_s_sleep(1);
        if ((++sp & 255u) == 0u) { if (xb_ld(&bar[XB_TMO])) break; if (sp > XB_SPIN_CAP) { atomicAdd(&bar[XB_TMO], 1u); break; } }
    }
    nloc = mine > 0u ? mine : 1u; nx = cnt > 0u ? cnt : 1u;
}

__device__ __forceinline__ void xcd_barrier(const XcdBarrier& b) {
    asm volatile("s_waitcnt vmcnt(0)" ::: "memory");
    __syncthreads();
    if (threadIdx.x == 0) {
        unsigned* bar = b.bar;
        __builtin_amdgcn_s_waitcnt(0);
        unsigned nloc = b.st[0], nx = b.st[1];
        if (nloc == 0u) { xcd_barrier_complete(bar, b.x, nloc, nx); b.st[0] = nloc; b.st[1] = nx; }
        const unsigned old = xb_add(&bar[XB_XSUB(b.x)], 1u);
        const unsigned gen = old / nloc;
        if (old + 1u == (gen + 1u) * nloc) {
            __builtin_amdgcn_fence(__ATOMIC_RELEASE, "agent");
            asm volatile("s_waitcnt vmcnt(0)" ::: "memory");
            const unsigned og = xb_add(&bar[XB_TOP], 1u);
            const unsigned tg = og / nx;
            if (og + 1u == (tg + 1u) * nx) xb_add(&bar[XB_TOPGEN], 1u);
            else XB_SPIN(xb_ld(&bar[XB_TOPGEN]) == tg, bar);
            __builtin_amdgcn_fence(__ATOMIC_ACQUIRE, "agent");
            xb_add(&bar[XB_XGEN(b.x)], 1u);
            asm volatile("s_waitcnt vmcnt(0)" ::: "memory");
        } else {
            XB_SPIN(xb_ld(&bar[XB_XGEN(b.x)]) == gen, bar);
            __builtin_amdgcn_fence(__ATOMIC_ACQUIRE, "agent");
            asm volatile("s_waitcnt vmcnt(0)" ::: "memory");
        }
    }
    __syncthreads();
}

struct Frame {
    lds8* lds;
    volatile LAS unsigned* MISC;
    gu32* ctl;
    int tid, lane, wave, vcu, G;
    const float *x, *mem, *norm_g, *w_in, *conv_w, *conv_b, *wq_m, *wk_m, *wv_m, *w_if, *b_if, *mnorm_g, *skip_m, *lam_q1, *lam_k1, *lam_q2, *lam_k2, *dnorm_g, *mem_norm_g, *w_mem_kv, *w_out, *final_g;
    float* out; unsigned char* ws;
};
#ifdef PROBE_NUM
#ifndef PROBE_TID
#define PROBE_TID 0
#endif
#define PROBE_ON(F) (blockIdx.x == 0 && threadIdx.x == PROBE_TID)
#define PROBE_T0(var) unsigned long long var = __builtin_amdgcn_s_memtime()
#ifdef PROBE_LITE
#define PROBE_ADD(F, slot, var) do { if ((slot) == 0 || (slot) >= 8) { const unsigned long long t1_ = __builtin_amdgcn_s_memtime(); if (PROBE_ON(F)) ((unsigned long long*)((F).ws + 512 * 1024))[slot] += t1_ - var; var = __builtin_amdgcn_s_memtime(); } } while (0)
#else
#define PROBE_ADD(F, slot, var) do { const unsigned long long t1_ = __builtin_amdgcn_s_memtime(); if (PROBE_ON(F)) ((unsigned long long*)((F).ws + 512 * 1024))[slot] += t1_ - var; var = __builtin_amdgcn_s_memtime(); } while (0)
#endif
#define PROBE_CNT(F, slot, n) do { if (PROBE_ON(F)) ((unsigned long long*)((F).ws + 512 * 1024))[slot] += (n); } while (0)
#else
#define PROBE_CNT(F, slot, n) do {} while (0)
#define PROBE_T0(var) do {} while (0)
#define PROBE_ADD(F, slot, var) do {} while (0)
#endif
__device__ __forceinline__ float wave_sum(float v) {
#pragma unroll
    for (int o = 1; o < 64; o <<= 1) v += __shfl_xor(v, o);
    return v;
}
__host__ __device__ __forceinline__ int fragidx(int row, int col) { return ((((row >> 5) * 8 + (col >> 4)) * 2 + ((col >> 3) & 1)) * 32 + (row & 31)) * 8 + (col & 7); }
template <bool FRAGM = false>
__device__ __forceinline__ void p0_transpose_item(const float* W, int K, int N, bf16* WT, int row_off, LAS float* scr, int item, int lane, const float* gk) {
    const int nblk = N / 32, kb = item / nblk, nb = item % nblk, k0 = 64 * kb, n0 = 32 * nb;
#pragma unroll 8
    for (int i = 0; i < 32; ++i) { const int kk = 2 * i + (lane >> 5); scr[kk * 33 + (lane & 31)] = W[(size_t)(k0 + kk) * N + n0 + (lane & 31)]; }
    LDS_WAIT(); asm volatile("" ::: "memory");
    const int c = lane & 7;
    float g[8];
#pragma unroll
    for (int j = 0; j < 8; ++j) g[j] = gk ? gk[k0 + 8 * c + j] : 1.f;
#pragma unroll
    for (int j = 0; j < 4; ++j) { const int n = (lane >> 3) + 8 * j; const LAS float* s = scr + (8 * c) * 33 + n;
        v4u o; o.x = pk2(s[0 * 33] * g[0], s[1 * 33] * g[1]); o.y = pk2(s[2 * 33] * g[2], s[3 * 33] * g[3]); o.z = pk2(s[4 * 33] * g[4], s[5 * 33] * g[5]); o.w = pk2(s[6 * 33] * g[6], s[7 * 33] * g[7]);
        if (FRAGM) *(GAS v4u*)(WT + fragidx(n0 + n, k0 + 8 * c)) = o; else *(GAS v4u*)(WT + (size_t)(row_off + n0 + n) * K + k0 + 8 * c) = o; }
    LDS_WAIT(); asm volatile("" ::: "memory");
}
template <int NR>
__device__ __forceinline__ void rms_rows_to_bf16(int lane, const float* x0, bf16* o0) {
    f32x4 v[NR][4]; float s[NR];
#pragma unroll
    for (int r = 0; r < NR; ++r) { const GAS f32x4* xr = (const GAS f32x4*)(x0 + (size_t)r * DM) + lane;
#pragma unroll
        for (int j = 0; j < 4; ++j) v[r][j] = __builtin_nontemporal_load(xr + 64 * j); }
#pragma unroll
    for (int r = 0; r < NR; ++r) { s[r] = 0.f;
#pragma unroll
        for (int j = 0; j < 4; ++j) s[r] += (v[r][j].x * v[r][j].x + v[r][j].y * v[r][j].y) + (v[r][j].z * v[r][j].z + v[r][j].w * v[r][j].w); }
#pragma unroll
    for (int o = 1; o < 64; o <<= 1) {
#pragma unroll
        for (int r = 0; r < NR; ++r) s[r] += __shfl_xor(s[r], o); }
#pragma unroll
    for (int r = 0; r < NR; ++r) { const float rstd = rsqrtf(s[r] * (1.f / DM) + NORM_EPS); GAS v2u* o8 = (GAS v2u*)(o0 + (size_t)r * DM) + lane;
#pragma unroll
        for (int j = 0; j < 4; ++j) { v2u w; w.x = pk2(v[r][j].x * rstd, v[r][j].y * rstd); w.y = pk2(v[r][j].z * rstd, v[r][j].w * rstd); o8[64 * j] = w; } }
}
__device__ __forceinline__ void p0_prologue(Frame& F) {
    LAS float* scr = (LAS float*)(F.lds + RING_OFF + F.wave * 16384);
    const int gw = F.vcu * NWAVES + F.wave, NGW = F.G * NWAVES;
    bf16* WIN = (bf16*)(F.ws + WS_WIN); bf16* WOUT = (bf16*)(F.ws + WS_WOUT); bf16* WMEM = (bf16*)(F.ws + WS_WMEM); bf16* WQKV = (bf16*)(F.ws + WS_WQKV);
    constexpr int I_IN = (DM / 64) * (INW / 32), I_OUT = (MIXW / 64) * (DM / 32), I_MEM = (DM / 64) * (DM / 32), I_HEAD = (HD / 64) * (HD / 32);
    constexpr int NITEMS = I_IN + I_OUT + I_MEM + 12 * I_HEAD;
    for (int it = gw; it < NITEMS; it += NGW) {
        int r = it;
        if (r < I_IN) { p0_transpose_item(F.w_in, DM, INW, WIN, 0, scr, r, F.lane, F.norm_g); continue; } r -= I_IN;
        if (r < I_OUT) { p0_transpose_item(F.w_out, MIXW, DM, WOUT, 0, scr, r, F.lane, nullptr); continue; } r -= I_OUT;
        if (r < I_MEM) { p0_transpose_item(F.w_mem_kv, DM, DM, WMEM, 0, scr, r, F.lane, F.mem_norm_g); continue; } r -= I_MEM;
        const int mh = r / I_HEAD, sub = r % I_HEAD, mat = mh >> 2, hh = mh & 3;
        if (mat == 0) p0_transpose_item<true>(F.wq_m + (size_t)hh * HD * HD, HD, HD, WQKV + (size_t)mh * HD * HD, 0, scr, sub, F.lane, nullptr);
        else if (mat == 1) p0_transpose_item<true>(F.wk_m + (size_t)hh * HD * HD, HD, HD, WQKV + (size_t)mh * HD * HD, 0, scr, sub, F.lane, nullptr);
        else p0_transpose_item<true>(F.wv_m + (size_t)hh * HD * HD, HD, HD, WQKV + (size_t)mh * HD * HD, 0, scr, sub, F.lane, nullptr);
    }
    bf16* Hb = (bf16*)(F.ws + WS_H); bf16* MEMN = (bf16*)(F.ws + WS_MEMN);
    for (int m4 = gw; m4 < (M + MEMROWS) / 4; m4 += NGW) { const int m = 4 * m4;
        if (m < M) rms_rows_to_bf16<4>(F.lane, F.x + (size_t)m * DM, Hb + (size_t)m * DM);
        else rms_rows_to_bf16<4>(F.lane, F.mem + (size_t)(m - M) * DM, MEMN + (size_t)(m - M) * DM);
    }
    const int gt = F.vcu * (NWAVES * 64) + F.tid, NGT = F.G * NWAVES * 64;
    float* ROWSS = (float*)(F.ws + WS_ROWSS);
    for (int i = gt; i < M; i += NGT) ROWSS[i] = 0.f;
    bf16* WGT = (bf16*)(F.ws + WS_WG);
    for (int it = gw; it < 2 * 512; it += NGW) {
        const int which = it >> 9, hd = it & 511, hh = hd >> 7, d = hd & 127; float sg[8];
#pragma unroll
        for (int g = 0; g < 8; ++g) sg[g] = 0.f;
#pragma unroll
        for (int half = 0; half < 2; ++half) { const int e = F.lane + 64 * half;
            if (which == 0) { const float qv = F.wq_m[((size_t)hh * HD + d) * HD + e], kv = F.wk_m[((size_t)hh * HD + d) * HD + e];
                const f32x4 a0 = *(const GAS f32x4*)(F.w_if + (hh * HD + e) * 8), a1 = *(const GAS f32x4*)(F.w_if + (hh * HD + e) * 8 + 4), b0 = *(const GAS f32x4*)(F.w_if + (512 + hh * HD + e) * 8), b1 = *(const GAS f32x4*)(F.w_if + (512 + hh * HD + e) * 8 + 4);
#pragma unroll
                for (int g = 0; g < 4; ++g) { sg[g] += qv * a0[g] + kv * b0[g]; sg[4 + g] += qv * a1[g] + kv * b1[g]; } }
            else { const float vv = F.wv_m[((size_t)hh * HD + d) * HD + e];
                const f32x4 a0 = *(const GAS f32x4*)(F.w_if + (1024 + hh * HD + e) * 8), a1 = *(const GAS f32x4*)(F.w_if + (1024 + hh * HD + e) * 8 + 4);
#pragma unroll
                for (int g = 0; g < 4; ++g) { sg[g] += vv * a0[g]; sg[4 + g] += vv * a1[g]; } } }
#pragma unroll
        for (int g = 0; g < 8; ++g) sg[g] = wave_sum(sg[g]);
        if (F.lane < 8) { float sv = sg[0];
#pragma unroll
            for (int g = 1; g < 8; ++g) sv = (F.lane == g) ? sg[g] : sv;
            const bf16 sh = f2bf(sv), sl = f2bf(sv - bf2f(sh));
            WGT[((which * 2 + 0) * 8 + F.lane) * 512 + hd] = sh; WGT[((which * 2 + 1) * 8 + F.lane) * 512 + hd] = sl; }
    }
#if !(EN_CROSS && EN_DIFF && EN_MLSTM)
    { v4u* Y4 = (v4u*)(F.ws + WS_Y); const size_t n16 = (size_t)M * MIXW * 2 / 16; for (size_t i = gt; i < n16; i += NGT) Y4[i] = (v4u){0u, 0u, 0u, 0u}; }
#endif
}

namespace att {
constexpr int L_K = 0, L_V = 16384, L_WS = 32768, L_XO = 34816, L_END = L_XO + 65536;
static_assert(L_END <= RING_BYTES, "attention LDS");
__device__ __forceinline__ void stage_kv(lds8* lds, const bf16* Kg, int pitchK, const bf16* Vg, int pitchV, int wave, int lane) {
    v4u kv[2], vv[2];
#pragma unroll
    for (int i = 0; i < 2; ++i) { const int chunk = wave + 8 * i; kv[i] = *(const GAS v4u*)(Kg + (size_t)lane * pitchK + chunk * 8); }
#pragma unroll
    for (int i = 0; i < 2; ++i) { const int p = wave + 8 * i, d0 = p >> 2, key = 16 * (p & 3) + (lane >> 2); vv[i] = *(const GAS v4u*)(Vg + (size_t)key * pitchV + d0 * 32 + (lane & 3) * 8); }
#pragma unroll
    for (int i = 0; i < 2; ++i) { const int chunk = wave + 8 * i; *(LAS v4u*)(lds + L_K + (chunk * 64 + lane) * 16) = kv[i]; }
#pragma unroll
    for (int i = 0; i < 2; ++i) { const int p = wave + 8 * i; *(LAS v4u*)(lds + L_V + p * 1024 + lane * 16) = vv[i]; }
}
template <int NQ, bool MASK>
__device__ __forceinline__ void tile_step(lds8* lds, const bf16x8* qf, int kchunk0, float C2, int kbase, int qg, float& m, float& l, f32x16* o, volatile LAS float* wsf, int lane) {
    const int r32 = lane & 31, hi = lane >> 5;
    f32x16 p0 = {}, p1 = {};
#pragma unroll
    for (int d0 = 0; d0 < NQ; ++d0) {
        const lds8* kp = lds + L_K + ((kchunk0 + 2 * d0 + hi) * 64 + r32) * 16;
        const bf16x8 a0 = ldfrag(kp), a1 = ldfrag(kp + 512);
        p0 = MFMA32(a0, qf[d0], p0); p1 = MFMA32(a1, qf[d0], p1);
    }
    float tmax = -1e30f;
#pragma unroll
    for (int r = 0; r < 16; ++r) { float s0 = p0[r] * C2, s1 = p1[r] * C2;
        if (MASK) { const int k0 = kbase + crow(r, hi); if (k0 > qg) s0 = -1e30f; if (k0 + 32 > qg) s1 = -1e30f; }
        p0[r] = s0; p1[r] = s1; tmax = fmaxf(tmax, fmaxf(s0, s1)); }
    tmax = fmaxf(tmax, __shfl_xor(tmax, 32));
    const float mnew = fmaxf(m, tmax), alpha = __builtin_amdgcn_exp2f(m - mnew); m = mnew;
    float ls = 0.f;
#pragma unroll
    for (int r = 0; r < 16; ++r) { p0[r] = __builtin_amdgcn_exp2f(p0[r] - mnew); p1[r] = __builtin_amdgcn_exp2f(p1[r] - mnew); ls += p0[r] + p1[r]; }
    l = l * alpha + ls;
    if (hi == 0) wsf[r32] = alpha;
#pragma unroll
    for (int r = 0; r < 16; ++r) { const float a = wsf[crow(r, hi)];
#pragma unroll
        for (int d0 = 0; d0 < 4; ++d0) o[d0][r] *= a; }
    bf16x8 pa[4]; pa[0] = pack8(p0, 0); pa[1] = pack8(p0, 8); pa[2] = pack8(p1, 0); pa[3] = pack8(p1, 8);
    const lds8* vb = lds + L_V + ((lane >> 4) & 1) * 32 + (lane & 3) * 8 + (4 * hi + ((lane & 15) >> 2)) * 64;
#pragma unroll
    for (int d0 = 0; d0 < 4; ++d0)
#pragma unroll
        for (int ks = 0; ks < 4; ++ks) { const s16x4 lo = vtr(vb + d0 * 4096 + ks * 1024), hh = vtr(vb + d0 * 4096 + ks * 1024 + 512);
            const bf16x8 vf = (bf16x8){lo[0], lo[1], lo[2], lo[3], hh[0], hh[1], hh[2], hh[3]};
            o[d0] = MFMA32(pa[ks], vf, o[d0]); }
}
__device__ __forceinline__ void finish_o(float l, f32x16* o, volatile LAS float* wsf, int lane) {
    const int r32 = lane & 31, hi = lane >> 5;
    l += __shfl_xor(l, 32);
    if (hi == 0) wsf[32 + r32] = __builtin_amdgcn_rcpf(l);
#pragma unroll
    for (int r = 0; r < 16; ++r) { const float a = wsf[32 + crow(r, hi)];
#pragma unroll
        for (int d0 = 0; d0 < 4; ++d0) o[d0][r] *= a; }
}
__device__ __forceinline__ void cross_unit(Frame& F, int b, int h, int qblk) {
    int tid_ = F.tid; asm volatile("" : "+v"(tid_));
    lds8* lds = F.lds + RING_OFF; const int lane = tid_ & 63, wave = __builtin_amdgcn_readfirstlane(tid_ >> 6), r32 = lane & 31, hi = lane >> 5;
    const bf16* P = (const bf16*)(F.ws + WS_P); const bf16* MKV = (const bf16*)(F.ws + WS_MEMKV); bf16* Y = (bf16*)(F.ws + WS_Y);
    const int row0 = b * SEQ + qblk * 256 + 32 * wave;
    bf16x8 qf[8];
#pragma unroll
    for (int d0 = 0; d0 < 8; ++d0) qf[d0] = *(const GAS bf16x8*)(PGRP(P, G_QC + h) + (size_t)(row0 + r32) * PP + d0 * 16 + hi * 8);
    float m = -1e30f, l = 0.f; f32x16 o[4];
#pragma unroll
    for (int d0 = 0; d0 < 4; ++d0) o[d0] = f32x16{};
    volatile LAS float* wsf = (volatile LAS float*)(lds + L_WS) + wave * 64;
    const float C2 = 1.0f;
    for (int kt = 0; kt < MEML / 64; ++kt) {
        __syncthreads();
        const bf16* Kg = MKV + (size_t)(b * MEML + kt * 64) * DM + h * HD;
        stage_kv(lds, Kg, DM, Kg + 512, DM, wave, lane);
        __syncthreads();
        tile_step<8, false>(lds, qf, 0, C2, 0, 0, m, l, o, wsf, lane);
    }
    finish_o(l, o, wsf, lane);
#pragma unroll
    for (int r = 0; r < 16; ++r) { const size_t row = (size_t)(row0 + crow(r, hi));
#pragma unroll
        for (int d0 = 0; d0 < 4; ++d0) { const int col = h * HD + 32 * d0 + r32; const float z = bf2f(PGRP(P, G_ZC + h)[row * PP + 32 * d0 + r32]);
            Y[row * MIXW + 1024 + col] = f2bf(o[d0][r] * siluf_(z)); } }
}
__device__ __forceinline__ void diff_unit(Frame& F, int b, int h, int qb, float lam) {
    int tid_ = F.tid; asm volatile("" : "+v"(tid_));
    lds8* lds = F.lds + RING_OFF; const int lane = tid_ & 63, wave = __builtin_amdgcn_readfirstlane(tid_ >> 6), r32 = lane & 31, hi = lane >> 5, map = wave >> 2, wq = wave & 3;
    const bf16* P = (const bf16*)(F.ws + WS_P); bf16* Y = (bf16*)(F.ws + WS_Y);
    const int q0 = qb * 128, row0 = b * SEQ + q0 + 32 * wq, NT = 2 * (qb + 1);
    bf16x8 qf[4];
#pragma unroll
    for (int d0 = 0; d0 < 4; ++d0) qf[d0] = *(const GAS bf16x8*)(PGRP(P, G_QD + h) + (size_t)(row0 + r32) * PP + map * 64 + d0 * 16 + hi * 8);
    float m = -1e30f, l = 0.f; f32x16 o[4];
#pragma unroll
    for (int d0 = 0; d0 < 4; ++d0) o[d0] = f32x16{};
    volatile LAS float* wsf = (volatile LAS float*)(lds + L_WS) + wave * 64;
    const float C2 = 0.125f * 1.4426950408889634f;
    const int qg = q0 + 32 * wq + r32;
    for (int kt = 0; kt < NT; ++kt) {
        __syncthreads();
        const bf16* Kg = PGRP(P, G_KD + h) + (size_t)(b * SEQ + kt * 64) * PP;
        const bf16* Vg = PGRP(P, G_VD + h) + (size_t)(b * SEQ + kt * 64) * PP;
        stage_kv(lds, Kg, PP, Vg, PP, wave, lane);
        __syncthreads();
        if (kt >= NT - 2) tile_step<4, true>(lds, qf, 8 * map, C2, kt * 64, qg, m, l, o, wsf, lane);
        else tile_step<4, false>(lds, qf, 8 * map, C2, 0, 0, m, l, o, wsf, lane);
    }
    finish_o(l, o, wsf, lane);
    LAS float* XO = (LAS float*)(lds + L_XO);
    if (map == 1) {
#pragma unroll
        for (int d0 = 0; d0 < 4; ++d0)
#pragma unroll
            for (int r = 0; r < 16; ++r) XO[((wq * 4 + d0) * 16 + r) * 64 + lane] = o[d0][r];
    }
    __syncthreads();
    if (map == 0) {
#pragma unroll
        for (int r = 0; r < 16; ++r) { float ss = 0.f;
#pragma unroll
            for (int d0 = 0; d0 < 4; ++d0) { const float od = o[d0][r] - lam * XO[((wq * 4 + d0) * 16 + r) * 64 + lane]; o[d0][r] = od; ss += od * od; }
            ss += __shfl_xor(ss, 1); ss += __shfl_xor(ss, 2); ss += __shfl_xor(ss, 4); ss += __shfl_xor(ss, 8); ss += __shfl_xor(ss, 16);
            const float rinv = rsqrtf(ss * (1.f / HD) + NORM_EPS) * 0.8f;
            const size_t row = (size_t)(row0 + crow(r, hi));
#pragma unroll
            for (int d0 = 0; d0 < 4; ++d0) { const int col = h * HD + 32 * d0 + r32; const float z = bf2f(PGRP(P, G_ZD + h)[row * PP + 32 * d0 + r32]);
                Y[row * MIXW + 512 + col] = f2bf(o[d0][r] * rinv * F.dnorm_g[col] * siluf_(z)); } }
    }
}

constexpr int D_K = 0, D_V = 49152, D_WS = 98304, D_XO = 0;
static_assert(D_WS + 2048 <= RING_BYTES, "diff attention LDS");
__device__ __forceinline__ void glds16(const void* g, unsigned lds_base) { unsigned sv;
    asm volatile("s_mov_b32 %0, m0\n\ts_mov_b32 m0, %2\n\ts_nop 0\n\tglobal_load_lds_dwordx4 %1, off\n\ts_mov_b32 m0, %0" : "=&s"(sv) : "v"(g), "s"(lds_base) : "memory"); }
#define ATT_WAIT_BAR() asm volatile("s_waitcnt vmcnt(0) lgkmcnt(0)\n\ts_barrier" ::: "memory")
__device__ __forceinline__ void d_qk(f32x16& p0, f32x16& p1, const lds8* kslot, int map, const bf16x8* qf, const f32x16& negm, int r32, int hi) {
    const lds8* kp = kslot + ((8 * map + hi) * 64 + r32) * 16;
#pragma unroll
    for (int d0 = 0; d0 < 4; ++d0) { const bf16x8 a0 = ldfrag(kp + d0 * 2048), a1 = ldfrag(kp + d0 * 2048 + 512);
        if (d0 == 0) { p0 = MFMA32(a0, qf[0], negm); p1 = MFMA32(a1, qf[0], negm); } else { p0 = MFMA32(a0, qf[d0], p0); p1 = MFMA32(a1, qf[d0], p1); } }
}
template <bool MASK>
__device__ __forceinline__ void d_softmax(f32x16& p0, f32x16& p1, bf16x8* pa, f32x16& negm, float& l, f32x16* o, volatile LAS float* wsf, int kbase, int qg, int r32, int hi) {
    if (MASK) {
#pragma unroll
        for (int r = 0; r < 16; ++r) { const int k0 = kbase + crow(r, hi); if (k0 > qg) p0[r] = -1e30f; if (k0 + 32 > qg) p1[r] = -1e30f; } }
    float ta = fmaxf(fmaxf(p0[0], p0[1]), p1[0]), tb = fmaxf(fmaxf(p0[2], p0[3]), p1[1]); ta = fmaxf(fmaxf(ta, p1[2]), p1[3]);
#pragma unroll
    for (int r = 4; r < 16; r += 4) { ta = fmaxf(fmaxf(ta, p0[r]), p0[r + 1]); tb = fmaxf(fmaxf(tb, p0[r + 2]), p0[r + 3]); ta = fmaxf(fmaxf(ta, p1[r]), p1[r + 1]); tb = fmaxf(fmaxf(tb, p1[r + 2]), p1[r + 3]); }
    float tmax = fmaxf(ta, tb); tmax = fmaxf(tmax, __shfl_xor(tmax, 32));
    if (__any(tmax > 8.0f)) {
        const float dl = fmaxf(tmax, 0.f);
#pragma unroll
        for (int r = 0; r < 16; ++r) { p0[r] -= dl; p1[r] -= dl; negm[r] -= dl; }
        const float f = __builtin_amdgcn_exp2f(-dl); l *= f;
        if (hi == 0) wsf[r32] = f;
#pragma unroll
        for (int r = 0; r < 16; ++r) { const float a = wsf[crow(r, hi)];
#pragma unroll
            for (int d0 = 0; d0 < 4; ++d0) o[d0][r] *= a; }
    }
    float ls = 0.f;
#pragma unroll
    for (int r = 0; r < 16; ++r) { p0[r] = __builtin_amdgcn_exp2f(p0[r]); p1[r] = __builtin_amdgcn_exp2f(p1[r]); ls += p0[r] + p1[r]; }
    l += ls;
    pa[0] = pack8(p0, 0); pa[1] = pack8(p0, 8); pa[2] = pack8(p1, 0); pa[3] = pack8(p1, 8);
}
struct VFrag { s16x4 lo, hh; };
constexpr int VDIST = 2;
#define D_VRD(buf, g) do { (buf).lo = vtr(vb.p[(g) >> 2] + ((g) & 3) * 4096); (buf).hh = vtr(vb.p[(g) >> 2] + ((g) & 3) * 4096 + 2048); } while (0)
#define D_VFR(buf) ((bf16x8){(buf).lo[0], (buf).lo[1], (buf).lo[2], (buf).lo[3], (buf).hh[0], (buf).hh[1], (buf).hh[2], (buf).hh[3]})
struct VBase { const lds8* p[4]; };
__device__ __forceinline__ VBase d_vbase(const lds8* vslot, int lane, int hi) { VBase v; const int q = (lane & 15) >> 2;
#pragma unroll
    for (int d0 = 0; d0 < 4; ++d0) v.p[d0] = vslot + (4 * hi + q) * 256 + ((d0 ^ q) * 64) + ((lane >> 4) & 1) * 32 + (lane & 3) * 8;
    return v; }
__device__ __forceinline__ void d_pv_head(VFrag* f, const VBase& vb) {
#pragma unroll
    for (int g = 0; g < VDIST; ++g) D_VRD(f[g], g);
}
template <bool KPRE>
__device__ __forceinline__ void d_pv_body(f32x16* o, VFrag* f, const VBase& vb, const bf16x8* pa, bf16x8* kf, const lds8* kp_next) {
#pragma unroll
    for (int g = 0; g < 16; ++g) {
        if (g + VDIST < 16) D_VRD(f[(g + VDIST) & 3], g + VDIST);
        o[g >> 2] = MFMA32(pa[g & 3], D_VFR(f[g & 3]), o[g >> 2]);
        __builtin_amdgcn_sched_barrier(0);
    }
}
__device__ __forceinline__ void d_qk_reg(f32x16& p0, f32x16& p1, const bf16x8* kf, const bf16x8* qf, const f32x16& negm) {
    p0 = MFMA32(kf[0], qf[0], negm); p1 = MFMA32(kf[1], qf[0], negm);
#pragma unroll
    for (int d0 = 1; d0 < 4; ++d0) { p0 = MFMA32(kf[2 * d0], qf[d0], p0); p1 = MFMA32(kf[2 * d0 + 1], qf[d0], p1); }
}

template <bool RMS>
__device__ __forceinline__ void att_rows_epilogue(const LAS float* OT, int nrows, size_t grow0, const bf16* Zg  , bf16* Y, int ycol0, const float* gn, float post, int tid) {
    const int ch = tid & 15;
    f32x4 g0 = {1.f, 1.f, 1.f, 1.f}, g1 = g0;
    if (RMS) { g0 = *(const GAS f32x4*)(gn + 8 * ch); g1 = *(const GAS f32x4*)(gn + 8 * ch + 4); }
    for (int r0 = 0; r0 < nrows; r0 += 32) { const int rr = r0 + (tid >> 4); const size_t row = grow0 + rr;
        const v4u zz = *(const GAS v4u*)(Zg + row * PP + 8 * ch);
        const f32x4 a0 = *(const LAS f32x4*)(OT + rr * 128 + 8 * ch), a1 = *(const LAS f32x4*)(OT + rr * 128 + 8 * ch + 4);
        float sc = 1.f;
        if (RMS) { float ss = (a0[0] * a0[0] + a0[1] * a0[1]) + (a0[2] * a0[2] + a0[3] * a0[3]) + (a1[0] * a1[0] + a1[1] * a1[1]) + (a1[2] * a1[2] + a1[3] * a1[3]);
            ss += __shfl_xor(ss, 1); ss += __shfl_xor(ss, 2); ss += __shfl_xor(ss, 4); ss += __shfl_xor(ss, 8);
            sc = rsqrtf(ss * (1.f / HD) + NORM_EPS) * post; }
        float yv[8];
#pragma unroll
        for (int e = 0; e < 8; ++e) { const float z = (e & 1) ? bfhi(zz[e >> 1]) : bflo(zz[e >> 1]); const float ov = (e < 4) ? a0[e & 3] : a1[e & 3], gg = (e < 4) ? g0[e & 3] : g1[e & 3];
            yv[e] = ov * sc * gg * siluf_(z); }
        v4u ow; ow.x = pk2(yv[0], yv[1]); ow.y = pk2(yv[2], yv[3]); ow.z = pk2(yv[4], yv[5]); ow.w = pk2(yv[6], yv[7]);
        *(GAS v4u*)(Y + row * MIXW + ycol0 + 8 * ch) = ow; }
}
template <int MAP>
__device__ __forceinline__ void diff_body(Frame& F, int b, int h, int qb, float lam, int tid_) {
    lds8* lds = F.lds + RING_OFF; const int lane = tid_ & 63, wave = __builtin_amdgcn_readfirstlane(tid_ >> 6), r32 = lane & 31, hi = lane >> 5, wq = wave & 3;
    const unsigned lds0 = (unsigned)(size_t)lds;
    const bf16* P = (const bf16*)(F.ws + WS_P); bf16* Y = (bf16*)(F.ws + WS_Y);
    const int q0 = qb * 128, row0 = b * SEQ + q0 + 32 * wq, NT = 2 * (qb + 1);
    const int kq = lane >> 4, kpos = lane & 15;
    const bf16* kg = PGRP(P, G_KD + h) + (size_t)(b * SEQ) * PP; const bf16* vg = PGRP(P, G_VD + h) + (size_t)(b * SEQ) * PP;
    const int keyA = 4 * wave + kq, keyB = 4 * (wave + 8) + kq;
    const bf16* ksrc0 = kg + (size_t)keyA * PP + (kpos ^ (keyA & 15)) * 8; const bf16* ksrc1 = kg + (size_t)keyB * PP + (kpos ^ (keyB & 15)) * 8;
    const bf16* vsrc0 = vg + (size_t)keyA * PP + (kpos ^ (kq << 2)) * 8;   const bf16* vsrc1 = vg + (size_t)keyB * PP + (kpos ^ (kq << 2)) * 8;
    const unsigned kdst0 = lds0 + D_K + wave * 1024, kdst1 = kdst0 + 8192, vdst0 = lds0 + D_V + wave * 1024, vdst1 = vdst0 + 8192;
#define DMA_K(t, ks) do { const size_t go_ = (size_t)(t) * 64 * PP; glds16(ksrc0 + go_, (unsigned)__builtin_amdgcn_readfirstlane(kdst0 + (ks))); glds16(ksrc1 + go_, (unsigned)__builtin_amdgcn_readfirstlane(kdst1 + (ks))); } while (0)
#define DMA_V(t, vs) do { const size_t go_ = (size_t)(t) * 64 * PP; glds16(vsrc0 + go_, (unsigned)__builtin_amdgcn_readfirstlane(vdst0 + (vs))); glds16(vsrc1 + go_, (unsigned)__builtin_amdgcn_readfirstlane(vdst1 + (vs))); } while (0)
    DMA_K(0, 0); DMA_V(0, 0); DMA_K(1, 16384);
    bf16x8 qf[4];
#pragma unroll
    for (int d0 = 0; d0 < 4; ++d0) qf[d0] = *(const GAS bf16x8*)(PGRP(P, G_QD + h) + (size_t)(row0 + r32) * PP + MAP * 64 + d0 * 16 + hi * 8);
    float l = 0.f; f32x16 o[4], negm = f32x16{}, p0, p1; bf16x8 pa[4], kf[8]; VFrag vf[4];
#pragma unroll
    for (int d0 = 0; d0 < 4; ++d0) o[d0] = f32x16{};
#pragma unroll
    for (int k = 0; k < 4; ++k) pa[k] = bf16x8{};
    volatile LAS float* wsf = (volatile LAS float*)(lds + D_WS) + wave * 64;
    const int qg = q0 + 32 * wq + r32;
    int kfo[4];
#pragma unroll
    for (int d0 = 0; d0 < 4; ++d0) kfo[d0] = r32 * 256 + (((8 * MAP + 2 * d0 + hi) ^ (r32 & 15)) << 4);
    const lds8* kfb = lds + D_K;
    ATT_WAIT_BAR();
#pragma unroll
    for (int j = 0; j < 8; ++j) kf[j] = ldfrag(kfb + kfo[j >> 1] + (j & 1) * 8192);
    int kc = 0, kn = 16384, kn2 = 32768, vcur = 0, vprev = 0, vnext = 16384;
    PROBE_T0(tl_); PROBE_T0(ts_);
    for (int i = 0; i < NT; ++i) {
        if (i + 2 < NT) DMA_K(i + 2, kn2);
        if (i + 1 < NT) DMA_V(i + 1, vnext);
        const bool msk = (i >= NT - 2), more = (i + 1 < NT);
        PROBE_ADD(F, 5, ts_);
        if (MAP == 0) {
            const VBase vb = d_vbase(lds + D_V + vcur, lane, hi);
            d_qk_reg(p0, p1, kf, qf, negm);
            __builtin_amdgcn_sched_barrier(0);
            if (more) {
#pragma unroll
                for (int j = 0; j < 8; ++j) kf[j] = ldfrag(kfb + kn + kfo[j >> 1] + (j & 1) * 8192); }
            d_pv_head(vf, vb);
            __builtin_amdgcn_sched_barrier(0);
            PROBE_ADD(F, 2, ts_);
            if (msk) d_softmax<true>(p0, p1, pa, negm, l, o, wsf, i * 64, qg, r32, hi); else d_softmax<false>(p0, p1, pa, negm, l, o, wsf, 0, 0, r32, hi);
            __builtin_amdgcn_sched_barrier(0);
            PROBE_ADD(F, 3, ts_);
            d_pv_body<false>(o, vf, vb, pa, kf, kfb);
            PROBE_ADD(F, 4, ts_);
        } else {
            const VBase vb = d_vbase(lds + D_V + vprev, lane, hi);
            if (i > 0) { d_pv_head(vf, vb); __builtin_amdgcn_sched_barrier(0); d_pv_body<false>(o, vf, vb, pa, kf, kfb); }
            d_qk_reg(p0, p1, kf, qf, negm);
            __builtin_amdgcn_sched_barrier(0);
            if (more) {
#pragma unroll
                for (int j = 0; j < 8; ++j) kf[j] = ldfrag(kfb + kn + kfo[j >> 1] + (j & 1) * 8192); }
            if (msk) d_softmax<true>(p0, p1, pa, negm, l, o, wsf, i * 64, qg, r32, hi); else d_softmax<false>(p0, p1, pa, negm, l, o, wsf, 0, 0, r32, hi);
        }
        ATT_WAIT_BAR();
        PROBE_ADD(F, 1, ts_);
        { const int t_ = kc; kc = kn; kn = kn2; kn2 = t_; }
        vprev = vcur; vcur = vnext; vnext = (vnext == 32768) ? 0 : vnext + 16384;
    }
    PROBE_ADD(F, 0, tl_); PROBE_CNT(F, 7, 1000000ull * NT);
    if (MAP == 1) { const VBase vb = d_vbase(lds + D_V + vprev, lane, hi); d_pv_head(vf, vb); d_pv_body<false>(o, vf, vb, pa, kf, kfb); }
#undef DMA_K
#undef DMA_V
    finish_o(l, o, wsf, lane);
    ATT_WAIT_BAR();
    LAS float* XO = (LAS float*)(lds + D_XO);
    if (MAP == 1) {
#pragma unroll
        for (int d0 = 0; d0 < 4; ++d0)
#pragma unroll
            for (int r = 0; r < 16; ++r) XO[((wq * 4 + d0) * 16 + r) * 64 + lane] = o[d0][r];
    }
    ATT_WAIT_BAR();
    LAS float* OT = (LAS float*)(lds + 65536);
    if (MAP == 0) {
#pragma unroll
        for (int r = 0; r < 16; ++r)
#pragma unroll
            for (int d0 = 0; d0 < 4; ++d0) OT[(32 * wq + crow(r, hi)) * 128 + 32 * d0 + r32] = o[d0][r] - lam * XO[((wq * 4 + d0) * 16 + r) * 64 + lane];
    }
    ATT_WAIT_BAR();
    att_rows_epilogue<true>(OT, 128, (size_t)(b * SEQ + q0), PGRP(P, G_ZD + h), Y, 512 + h * HD, F.dnorm_g + h * HD, 0.8f, tid_);
}
__device__ __forceinline__ void diff_unit2(Frame& F, int b, int h, int qb, float lam) {
    int tid_ = F.tid; asm volatile("" : "+v"(tid_));
    const int wave = __builtin_amdgcn_readfirstlane(tid_ >> 6);
    __syncthreads();
    if (wave < 4) diff_body<0>(F, b, h, qb, lam, tid_); else diff_body<1>(F, b, h, qb, lam, tid_);
}

constexpr int X_K = 0, X_V = 65536;
__device__ __forceinline__ void cross_pair(Frame& F, int b, int h, int qblk0) {
    int tid_ = F.tid; asm volatile("" : "+v"(tid_));
    lds8* lds = F.lds + RING_OFF; const int lane = tid_ & 63, wave = __builtin_amdgcn_readfirstlane(tid_ >> 6), r32 = lane & 31, hi = lane >> 5;
    const unsigned lds0 = (unsigned)(size_t)lds;
    const bf16* P = (const bf16*)(F.ws + WS_P); const bf16* MKV = (const bf16*)(F.ws + WS_MEMKV); bf16* Y = (bf16*)(F.ws + WS_Y);
    const bf16* kg = MKV + ((size_t)h * MEMROWS + (size_t)b * MEML) * HD; const bf16* vg = MKV + ((size_t)(4 + h) * MEMROWS + (size_t)b * MEML) * HD;
    const int kq = lane >> 4, kpos = lane & 15;
    volatile LAS float* wsf = (volatile LAS float*)(F.lds + PHM_OFF) + wave * 64;
    for (int qi = 0; qi < 2; ++qi) {
        __syncthreads();
#pragma unroll
        for (int t = 0; t < 4; ++t)
#pragma unroll
            for (int i = 0; i < 2; ++i) { const int p = wave + 8 * i, key = 64 * t + 4 * p + kq;
                glds16(kg + (size_t)key * HD + (kpos ^ (key & 15)) * 8, (unsigned)__builtin_amdgcn_readfirstlane(lds0 + X_K + t * 16384 + p * 1024));
                glds16(vg + (size_t)key * HD + (kpos ^ (kq << 2)) * 8, (unsigned)__builtin_amdgcn_readfirstlane(lds0 + X_V + t * 16384 + p * 1024)); }
        const int row0 = b * SEQ + (qblk0 + qi) * 256 + 32 * wave;
        bf16x8 qf[8];
#pragma unroll
        for (int d0 = 0; d0 < 8; ++d0) qf[d0] = *(const GAS bf16x8*)(PGRP(P, G_QC + h) + (size_t)(row0 + r32) * PP + d0 * 16 + hi * 8);
        float l = 0.f; f32x16 o[4], negm = f32x16{}, p0, p1; bf16x8 pa[4]; VFrag vf[4];
#pragma unroll
        for (int d0 = 0; d0 < 4; ++d0) o[d0] = f32x16{};
        ATT_WAIT_BAR();
#pragma unroll 1
        for (int t = 0; t < 4; ++t) {
            const lds8* kb = lds + X_K + t * 16384; const VBase vb = d_vbase(lds + X_V + t * 16384, lane, hi);
#pragma unroll
            for (int d0 = 0; d0 < 8; ++d0) { const int ko = r32 * 256 + (((2 * d0 + hi) ^ (r32 & 15)) << 4); const bf16x8 a0 = ldfrag(kb + ko), a1 = ldfrag(kb + ko + 8192);
                if (d0 == 0) { p0 = MFMA32(a0, qf[0], negm); p1 = MFMA32(a1, qf[0], negm); } else { p0 = MFMA32(a0, qf[d0], p0); p1 = MFMA32(a1, qf[d0], p1); } }
            d_pv_head(vf, vb);
            __builtin_amdgcn_sched_barrier(0);
            d_softmax<false>(p0, p1, pa, negm, l, o, wsf, 0, 0, r32, hi);
            __builtin_amdgcn_sched_barrier(0);
            d_pv_body<false>(o, vf, vb, pa, nullptr, nullptr);
        }
        finish_o(l, o, wsf, lane);
        ATT_WAIT_BAR();
        LAS float* OT = (LAS float*)lds;
#pragma unroll
        for (int r = 0; r < 16; ++r)
#pragma unroll
            for (int d0 = 0; d0 < 4; ++d0) OT[(32 * wave + crow(r, hi)) * 128 + 32 * d0 + r32] = o[d0][r];
        ATT_WAIT_BAR();
        att_rows_epilogue<false>(OT, 256, (size_t)(b * SEQ + (qblk0 + qi) * 256), PGRP(P, G_ZC + h), Y, 1024 + h * HD, nullptr, 1.f, tid_);
    }
}
}

namespace ml {
constexpr int L_XC = 0, L_XM = 32768, L_KT = 65536, L_VT = 98304;
constexpr float KSCALE = 0.08838834764831845f;
struct ConvRows { v4u rows[7]; };
__device__ __forceinline__ void conv_load(ConvRows& R, const bf16* P, int b, int c, int h, int tid) {
    const int ch = tid & 15, tg = tid >> 4, s0 = c * LCH + 4 * tg;
    const bf16* src = PGRP(P, G_XM + h) + (size_t)(b * SEQ + s0) * PP + ch * 8;
    const v4u zero = (v4u){0u, 0u, 0u, 0u};
#pragma unroll
    for (int j = 0; j < 7; ++j) R.rows[j] = (s0 + j - 3 >= 0) ? *(const GAS v4u*)(src + (ptrdiff_t)(j - 3) * PP) : zero;
}
__device__ __forceinline__ void conv_store(const ConvRows& R, lds8* XC, lds8* XM, int h, const float* conv_w, const float* conv_b, int tid) {
    const int ch = tid & 15, tg = tid >> 4, col = h * HD + ch * 8;
    f32x4 w[4][2], bias[2];
#pragma unroll
    for (int j = 0; j < 4; ++j) { w[j][0] = *(const GAS f32x4*)(conv_w + j * 512 + col); w[j][1] = *(const GAS f32x4*)(conv_w + j * 512 + col + 4); }
    bias[0] = *(const GAS f32x4*)(conv_b + col); bias[1] = *(const GAS f32x4*)(conv_b + col + 4);
#pragma unroll
    for (int i = 0; i < 4; ++i) { float y[8];
#pragma unroll
        for (int e = 0; e < 8; ++e) { float v = bias[e >> 2][e & 3];
#pragma unroll
            for (int j = 0; j < 4; ++j) { const unsigned wv = R.rows[i + j][e >> 1]; v += w[j][e >> 2][e & 3] * ((e & 1) ? bfhi(wv) : bflo(wv)); }
            y[e] = siluf_(v); }
        v4u o; o.x = pk2(y[0], y[1]); o.y = pk2(y[2], y[3]); o.z = pk2(y[4], y[5]); o.w = pk2(y[6], y[7]);
        const int t = 4 * tg + i;
        *(LAS v4u*)(XC + swz(t, ch)) = o; *(LAS v4u*)(XM + swz(t, ch)) = R.rows[i + 3]; }
}
__device__ __forceinline__ void stage_conv(lds8* XC, lds8* XM, const bf16* P, int b, int c, int h, const float* conv_w, const float* conv_b, int tid) {
    ConvRows R; conv_load(R, P, b, c, h, tid); conv_store(R, XC, XM, h, conv_w, conv_b, tid);
}
__device__ __forceinline__ float logsig(float f) { return fminf(f, 0.f) - log1pf(__expf(-fabsf(f))); }
__device__ __forceinline__ void store_accT(lds8* T, const f32x16& acc, int ib, int jb, int r32, int hi) {
#pragma unroll
    for (int rq = 0; rq < 4; ++rq) { v2u w; w.x = pk2(acc[4 * rq], acc[4 * rq + 1]); w.y = pk2(acc[4 * rq + 2], acc[4 * rq + 3]);
        *(LAS v2u*)(T + swz(32 * jb + r32, 4 * ib + rq) + 8 * hi) = w; }
}
__device__ __forceinline__ void m1_unit(Frame& F, int b, int c) {
    lds8* lds = F.lds + RING_OFF; lds8 *XC = lds + L_XC, *XM = lds + L_XM, *KT = lds + L_KT, *VT = lds + L_VT;
    LAS float* GA = (LAS float*)(F.lds + PHM_OFF); LAS float* WA = GA + 1024; LAS float* NL = WA + 512;
    int tid = F.tid; asm volatile("" : "+v"(tid));
    const int lane = tid & 63, wave = __builtin_amdgcn_readfirstlane(tid >> 6), r32 = lane & 31, hi = lane >> 5;
    const bf16* P = (const bf16*)(F.ws + WS_P); const bf16* WQKV = (const bf16*)(F.ws + WS_WQKV);
    float* BBg = (float*)(F.ws + WS_BB); float* Ug = (float*)(F.ws + WS_U); float* CUg = (float*)(F.ws + WS_CU);
    float* MLOC = (float*)(F.ws + WS_MLOC); float* BEND = (float*)(F.ws + WS_BEND); float* NLOC = (float*)(F.ws + WS_NLOC); float* CLOC = (float*)(F.ws + WS_CLOC);
    const bf16* WGT = (const bf16*)(F.ws + WS_WG);
    LAS float* GP = NL + 128;
    {
        const int tbg = wave & 3, which = wave >> 2; f32x16 gacc = {};
        for (int h = 0; h < NH; ++h) {
            __syncthreads();
            stage_conv(XC, XM, P, b, c, h, F.conv_w, F.conv_b, tid);
            __syncthreads();
            const lds8* XS = which ? XM : XC;
#pragma unroll
            for (int ds = 0; ds < 8; ++ds) { const bf16x8 A = ldfrag(XS + swz(32 * tbg + r32, 2 * ds + hi));
#pragma unroll
                for (int v = 0; v < 2; ++v) { bf16x8 B = {}; if (r32 < 8) B = *(const GAS bf16x8*)(WGT + (size_t)((which * 2 + v) * 8 + r32) * 512 + h * HD + 16 * ds + 8 * hi);
                    gacc = MFMA32(A, B, gacc); } }
        }
        if (which == 1 && r32 < 8) {
#pragma unroll
            for (int r = 0; r < 16; ++r) GP[(32 * tbg + crow(r, hi)) * 8 + r32] = gacc[r]; }
        __syncthreads();
        if (which == 0 && r32 < 8) { const float bias = F.b_if[r32];
#pragma unroll
            for (int r = 0; r < 16; ++r) { const int tt = 32 * tbg + crow(r, hi); GA[tt * 8 + r32] = gacc[r] + GP[tt * 8 + r32] + bias; } }
    }
    __syncthreads();
    if (wave < 4) {
        const int hd = wave, t0 = 2 * lane, t1 = t0 + 1;
        const float i0 = GA[t0 * 8 + hd], i1 = GA[t1 * 8 + hd], lf0 = logsig(GA[t0 * 8 + 4 + hd]), lf1 = logsig(GA[t1 * 8 + 4 + hd]);
        const float ps = lf0 + lf1; float xs = ps;
#pragma unroll
        for (int o = 1; o < 64; o <<= 1) { const float y = __shfl_up(xs, o); if (lane >= o) xs += y; }
        const float excl = xs - ps, bb0 = excl + lf0, bb1 = excl + ps, u0 = i0 - bb0, u1 = i1 - bb1;
        float xm = fmaxf(u0, u1);
#pragma unroll
        for (int o = 1; o < 64; o <<= 1) { const float y = __shfl_up(xm, o); if (lane >= o) xm = fmaxf(xm, y); }
        float ex = __shfl_up(xm, 1); if (lane == 0) ex = -1e30f;
        const float cu0 = fmaxf(ex, u0), cu1 = fmaxf(cu0, u1);
        const float umax = __shfl(xm, 63), bend = __shfl(bb1, 63);
        WA[hd * 128 + t0] = __expf(u0 - umax); WA[hd * 128 + t1] = __expf(u1 - umax);
        const size_t idx = (size_t)(b * NH + hd) * SEQ + c * LCH + t0;
        *(f32x2*)(BBg + idx) = (f32x2){bb0, bb1}; *(f32x2*)(Ug + idx) = (f32x2){u0, u1}; *(f32x2*)(CUg + idx) = (f32x2){cu0, cu1};
        if (lane == 0) { MLOC[(b * NH + hd) * NCH + c] = bend + umax; BEND[(b * NH + hd) * NCH + c] = bend; }
    }
    const int tb = wave & 3, eh = wave >> 2, u0i = (b * NCH + c) * NH;
    for (int h = 0; h < NH; ++h) {
        __syncthreads();
        if (tid < 128) NL[tid] = 0.f;
        stage_conv(XC, XM, P, b, c, h, F.conv_w, F.conv_b, tid);
        __syncthreads();
        float wa16[16];
#pragma unroll
        for (int r = 0; r < 16; ++r) wa16[r] = WA[h * 128 + 32 * tb + crow(r, hi)];
#pragma unroll
        for (int mat = 1; mat < 3; ++mat) {
            const lds8* XS = (mat == 1) ? XC : XM; const bf16* WT = WQKV + (size_t)(mat * 4 + h) * HD * HD;
#pragma unroll
            for (int ebi = 0; ebi < 2; ++ebi) { const int eb = 2 * eh + ebi; f32x16 acc = {};
#pragma unroll
                for (int ds = 0; ds < 8; ++ds) { const bf16x8 A = ldfrag(XS + swz(32 * tb + r32, 2 * ds + hi)); const bf16x8 B = *(const GAS bf16x8*)(WT + ((eb * 8 + ds) * 64 + lane) * 8);
                    acc = MFMA32(A, B, acc); }
                if (mat == 1) { float nl = 0.f;
#pragma unroll
                    for (int r = 0; r < 16; ++r) { acc[r] *= KSCALE; nl += acc[r] * wa16[r]; }
                    nl += __shfl_xor(nl, 32); if (hi == 0) atomicAdd((float*)(NL + 32 * eb + r32), nl);
                    store_accT(KT, acc, tb, eb, r32, hi);
                } else {
#pragma unroll
                    for (int r = 0; r < 16; ++r) acc[r] *= wa16[r];
                    store_accT(VT, acc, tb, eb, r32, hi);
                } }
        }
        __syncthreads();
        { const int vb = wave & 3; float* Cd = CLOC + (size_t)(u0i + h) * HD * HD;
#pragma unroll
            for (int kbi = 0; kbi < 2; ++kbi) { const int kb = 2 * (wave >> 2) + kbi; f32x16 acc = {};
#pragma unroll
                for (int ts = 0; ts < 8; ++ts) { const bf16x8 A = ldfrag(VT + swz(32 * vb + r32, 2 * ts + hi)), B = ldfrag(KT + swz(32 * kb + r32, 2 * ts + hi)); acc = MFMA32(A, B, acc); }
#pragma unroll
                for (int r = 0; r < 16; ++r) Cd[(32 * vb + crow(r, hi)) * HD + 32 * kb + r32] = acc[r]; }
            if (tid < 128) NLOC[(size_t)(u0i + h) * HD + tid] = NL[tid]; }
    }
}
__device__ __forceinline__ void m2_scan(Frame& F) {
    const float* CLOC = (const float*)(F.ws + WS_CLOC); const float* NLOC = (const float*)(F.ws + WS_NLOC); const float* MLOC = (const float*)(F.ws + WS_MLOC); const float* BEND = (const float*)(F.ws + WS_BEND);
    bf16* CIN = (bf16*)(F.ws + WS_CIN); float* NIN = (float*)(F.ws + WS_NIN); float* MIN = (float*)(F.ws + WS_MIN);
    const int NGT = F.G * NWAVES * 64;
    for (int gt = F.vcu * (NWAVES * 64) + F.tid; gt < BATCH * NH * 4096; gt += NGT) {
        const int bh = gt >> 12, e4 = gt & 4095, b = bh >> 2, h = bh & 3;
        float m = 0.f; f32x4 C = {0.f, 0.f, 0.f, 0.f}, n = {0.f, 0.f, 0.f, 0.f};
        for (int c = 0; c < NCH; ++c) {
            const size_t u = (size_t)(b * NCH + c) * NH + h;
            v2u w; w.x = pk2(C.x, C.y); w.y = pk2(C.z, C.w); *(GAS v2u*)(CIN + u * HD * HD + fragidx((e4 * 4) >> 7, (e4 * 4) & 127)) = w;
            const float mloc = MLOC[bh * NCH + c], bend = BEND[bh * NCH + c];
            const float mnew = fmaxf(bend + m, mloc), dec = __expf(bend + m - mnew), wl = __expf(mloc - mnew);
            const f32x4 cl = *(const GAS f32x4*)(CLOC + u * HD * HD + e4 * 4);
            C = C * dec + cl * wl;
            if (e4 < 32) { *(GAS f32x4*)(NIN + u * HD + e4 * 4) = n; const f32x4 nl = *(const GAS f32x4*)(NLOC + u * HD + e4 * 4); n = n * dec + nl * wl; }
            if (e4 == 0) MIN[u] = m;
            m = mnew;
        }
    }
}
__device__ __forceinline__ void m3_unit(Frame& F, int b, int c, int h) {
    lds8* lds = F.lds + RING_OFF; lds8 *XC = lds + L_XC, *XQ = lds + L_XM, *KK = lds + L_KT, *VT = lds + L_VT;
    LAS float* US = (LAS float*)(F.lds + PHM_OFF); LAS float *MT = US + 128, *BT = MT + 128, *IT = BT + 128, *NI = IT + 128, *LNS = NI + 128; volatile LAS float* WSC = (volatile LAS float*)(LNS + 512);
    int tid = F.tid; asm volatile("" : "+v"(tid));
    const int lane = tid & 63, wave = __builtin_amdgcn_readfirstlane(tid >> 6), r32 = lane & 31, hi = lane >> 5;
    const bf16* P = (const bf16*)(F.ws + WS_P); const bf16* WQKV = (const bf16*)(F.ws + WS_WQKV); bf16* Y = (bf16*)(F.ws + WS_Y);
    const size_t u = (size_t)(b * NCH + c) * NH + h; const int bh = b * NH + h;
    const bf16* CIN = (const bf16*)(F.ws + WS_CIN) + u * HD * HD;
    PROBE_T0(t3_);
    const int tb = wave & 3, vh = wave >> 2, tl = 32 * tb + r32;
    ConvRows R; conv_load(R, P, b, c, h, tid);
    bf16x8 wvf[8], wqf[8], cf[2][8];
    { const bf16* WV = WQKV + (size_t)(2 * 4 + h) * HD * HD; const bf16* WQK = WQKV + (size_t)((wave >> 2) * 4 + h) * HD * HD;
#pragma unroll
      for (int ds = 0; ds < 8; ++ds) { wvf[ds] = *(const GAS bf16x8*)(WV + (((wave & 3) * 8 + ds) * 64 + lane) * 8); wqf[ds] = *(const GAS bf16x8*)(WQK + (((wave & 3) * 8 + ds) * 64 + lane) * 8); }
#pragma unroll
      for (int d0 = 0; d0 < 2; ++d0)
#pragma unroll
          for (int ks = 0; ks < 8; ++ks) cf[d0][ks] = *(const GAS bf16x8*)(CIN + (((2 * vh + d0) * 8 + ks) * 64 + lane) * 8); }
    float sm_u = 0.f, sm_cu = 0.f, sm_bb = 0.f, sm_min = 0.f, sm_n = 0.f;
    if (tid < 128) { const size_t idx = (size_t)bh * SEQ + c * LCH + tid; sm_min = ((const float*)(F.ws + WS_MIN))[u];
        sm_u = ((const float*)(F.ws + WS_U))[idx]; sm_cu = ((const float*)(F.ws + WS_CU))[idx]; sm_bb = ((const float*)(F.ws + WS_BB))[idx]; sm_n = ((const float*)(F.ws + WS_NIN))[u * HD + tid]; }
    __syncthreads();
    conv_store(R, XC, XQ, h, F.conv_w, F.conv_b, tid);
    if (tid < 128) { const float Mv = fmaxf(sm_min, sm_cu); US[tid] = sm_u; MT[tid] = Mv; BT[tid] = sm_bb; IT[tid] = __expf(sm_min - Mv); NI[tid] = sm_n; }
    __syncthreads();
    PROBE_ADD(F, 20, t3_);
    {
        const int vb = wave & 3;
#pragma unroll
        for (int sbi = 0; sbi < 2; ++sbi) { const int sb = 2 * (wave >> 2) + sbi; f32x16 acc = {};
#pragma unroll
            for (int ds = 0; ds < 8; ++ds) { const bf16x8 A = ldfrag(XQ + swz(32 * sb + r32, 2 * ds + hi)); acc = MFMA32(A, wvf[ds], acc); }
            store_accT(VT, acc, sb, vb, r32, hi); }
    }
    __syncthreads();
    PROBE_ADD(F, 21, t3_);
    {
        const int mat = wave >> 2, eb = wave & 3; lds8* DST = mat == 0 ? XQ : KK;
#pragma unroll
        for (int tb2 = 0; tb2 < 4; ++tb2) { f32x16 acc = {};
#pragma unroll
            for (int ds = 0; ds < 8; ++ds) { const bf16x8 B = ldfrag(XC + swz(32 * tb2 + r32, 2 * ds + hi)); acc = MFMA32(wqf[ds], B, acc); }
            if (mat == 1) {
#pragma unroll
                for (int r = 0; r < 16; ++r) acc[r] *= KSCALE; }
            store_accT(DST, acc, eb, tb2, r32, hi); }
    }
    __syncthreads();
    PROBE_ADD(F, 22, t3_);
    bf16x8 qf[8];
#pragma unroll
    for (int es = 0; es < 8; ++es) qf[es] = ldfrag(XQ + swz(tl, 2 * es + hi));
    f32x16 o[2], cq[2];
#pragma unroll
    for (int d0 = 0; d0 < 2; ++d0) { cq[d0] = f32x16{};
#pragma unroll
        for (int ks = 0; ks < 8; ++ks) cq[d0] = MFMA32(qf[ks], cf[d0][ks], cq[d0]);
        __builtin_amdgcn_sched_barrier(0); }
    PROBE_ADD(F, 23, t3_);
    float nq = 0.f;
#pragma unroll
    for (int es = 0; es < 8; ++es)
#pragma unroll
        for (int j = 0; j < 8; ++j) nq += bf2f((bf16)qf[es][j]) * NI[16 * es + 8 * hi + j];
    nq += __shfl_xor(nq, 32);
    __builtin_amdgcn_sched_barrier(0);
    PROBE_ADD(F, 24, t3_);
    const float Mt = MT[tl];
    bf16x8 pa[4][2]; float dsum = 0.f;
#pragma unroll
    for (int sb = 0; sb < 4; ++sb) { f32x16 p = {};
        if (sb <= tb) {
#pragma unroll
            for (int es = 0; es < 8; ++es) { const bf16x8 A = ldfrag(KK + swz(32 * sb + r32, 2 * es + hi)); p = MFMA32(A, qf[es], p); }
#pragma unroll
            for (int r = 0; r < 16; ++r) { const int sl = 32 * sb + crow(r, hi); const float e = __expf(US[sl] - Mt); p[r] = (sl <= tl) ? p[r] * e : 0.f; dsum += p[r]; }
        }
        pa[sb][0] = pack8(p, 0); pa[sb][1] = pack8(p, 8);
        __builtin_amdgcn_sched_barrier(0); }
    dsum += __shfl_xor(dsum, 32);
    PROBE_ADD(F, 25, t3_);
#pragma unroll
    for (int d0 = 0; d0 < 2; ++d0) { const int vrow = 64 * vh + 32 * d0 + r32; o[d0] = f32x16{};
#pragma unroll
        for (int ks = 0; ks < 8; ++ks) { if ((ks >> 1) <= tb) { const v2u lo = *(const LAS v2u*)(VT + swz(vrow, 2 * ks) + 8 * hi), hh = *(const LAS v2u*)(VT + swz(vrow, 2 * ks + 1) + 8 * hi);
                const v4u bw = (v4u){lo.x, lo.y, hh.x, hh.y}; o[d0] = MFMA32(pa[ks >> 1][ks & 1], __builtin_bit_cast(bf16x8, bw), o[d0]); } }
        __builtin_amdgcn_sched_barrier(0); }
    PROBE_ADD(F, 26, t3_);
    const float inter = IT[tl], den = dsum + inter * nq, clampv = __expf(-(BT[tl] + Mt)), rden = __builtin_amdgcn_rcpf(fmaxf(fabsf(den), clampv));
    volatile LAS float* wsc = WSC + wave * 64;
    if (hi == 0) { wsc[r32] = rden; wsc[32 + r32] = inter; }
    __syncthreads();
    LAS float* HT = (LAS float*)(lds + L_XM);
#pragma unroll
    for (int r = 0; r < 16; ++r) { const int tr = crow(r, hi); const float rd = wsc[tr], it = wsc[32 + tr];
#pragma unroll
        for (int d0 = 0; d0 < 2; ++d0) HT[(32 * tb + tr) * HD + 64 * vh + 32 * d0 + r32] = (o[d0][r] + it * cq[d0][r]) * rd; }
    __syncthreads();
    PROBE_ADD(F, 27, t3_);
    {
        const int ch = tid & 15, col0 = h * HD + 8 * ch;
        const f32x4 mg0 = *(const GAS f32x4*)(F.mnorm_g + col0), mg1 = *(const GAS f32x4*)(F.mnorm_g + col0 + 4), sk0 = *(const GAS f32x4*)(F.skip_m + col0), sk1 = *(const GAS f32x4*)(F.skip_m + col0 + 4);
#pragma unroll
        for (int ps = 0; ps < 4; ++ps) { const int tt = (tid >> 4) + 32 * ps; const size_t row = (size_t)(b * SEQ + c * LCH + tt);
            const v4u om = *(const GAS v4u*)(PGRP(P, G_OM + h) + row * PP + 8 * ch), zm = *(const GAS v4u*)(PGRP(P, G_ZM + h) + row * PP + 8 * ch);
            const f32x4 h0 = *(const LAS f32x4*)(HT + tt * HD + 8 * ch), h1 = *(const LAS f32x4*)(HT + tt * HD + 8 * ch + 4);
            const v4u xc = *(const LAS v4u*)(XC + swz(tt, ch));
            float g[8]; float s1 = 0.f, s2 = 0.f;
#pragma unroll
            for (int e = 0; e < 8; ++e) { const unsigned w = om[e >> 1]; const float ov = (e & 1) ? bfhi(w) : bflo(w); const float hv = (e < 4) ? h0[e & 3] : h1[e & 3]; const float v = hv * sigmoidf_(ov); g[e] = v; s1 += v; s2 += v * v; }
#pragma unroll
            for (int sh = 1; sh < 16; sh <<= 1) { s1 += __shfl_xor(s1, sh); s2 += __shfl_xor(s2, sh); }
            const float mean = s1 * (1.f / HD), var = s2 * (1.f / HD) - mean * mean, rstd = rsqrtf(fmaxf(var, 0.f) + NORM_EPS);
            float yv[8];
#pragma unroll
            for (int e = 0; e < 8; ++e) { const float zz = (e & 1) ? bfhi(zm[e >> 1]) : bflo(zm[e >> 1]), xv = (e & 1) ? bfhi(xc[e >> 1]) : bflo(xc[e >> 1]);
                const float mg = (e < 4) ? mg0[e & 3] : mg1[e & 3], sk = (e < 4) ? sk0[e & 3] : sk1[e & 3];
                yv[e] = ((g[e] - mean) * rstd * mg + sk * xv) * siluf_(zz); }
            v4u ow; ow.x = pk2(yv[0], yv[1]); ow.y = pk2(yv[2], yv[3]); ow.z = pk2(yv[4], yv[5]); ow.w = pk2(yv[6], yv[7]);
            *(GAS v4u*)(Y + row * MIXW + col0) = ow; }
    }
    PROBE_ADD(F, 28, t3_);
}
}

__device__ __forceinline__ void final_norm(Frame& F) {
    const float* ROWSS = (const float*)(F.ws + WS_ROWSS);
    const int gw = F.vcu * NWAVES + F.wave, NGW = F.G * NWAVES;
    const int lane = (int)__builtin_amdgcn_mbcnt_hi(~0u, __builtin_amdgcn_mbcnt_lo(~0u, 0u));
    f32x4 gv[4];
#pragma unroll
    for (int j = 0; j < 4; ++j) gv[j] = *((const GAS f32x4*)F.final_g + lane + 64 * j);
    for (int m = gw; m < M; m += NGW) { const float rstd = rsqrtf(ROWSS[m] * (1.f / DM) + NORM_EPS); GAS f32x4* o = (GAS f32x4*)(F.out + (size_t)m * DM) + lane;
#pragma unroll
        for (int j = 0; j < 4; ++j) o[64 * j] = o[64 * j] * rstd * gv[j]; }
}

struct Args { const float* in[22]; float* out; unsigned char* ws; int ph_lo, ph_hi, li, pad; };
__global__ void __launch_bounds__(NWAVES * 64, 2) hybrid_fwd(Args args) {
    extern __shared__ __attribute__((aligned(16))) unsigned char lds[];
    Frame F;
    F.lds = (lds8*)lds;
    F.MISC = (volatile LAS unsigned*)(F.lds + MISC_OFF);
    F.tid = threadIdx.x; F.lane = F.tid & 63; F.wave = __builtin_amdgcn_readfirstlane(F.tid >> 6);
    F.G = gridDim.x; { const int bx = blockIdx.x; F.vcu = (F.G % 8 == 0) ? (bx % 8) * (F.G / 8) + bx / 8 : bx; }
    F.ws = args.ws; F.out = args.out; F.ctl = (gu32*)(args.ws + WS_CTL);
    F.x = args.in[0]; F.mem = args.in[1]; F.norm_g = args.in[2]; F.w_in = args.in[3]; F.conv_w = args.in[4]; F.conv_b = args.in[5]; F.wq_m = args.in[6]; F.wk_m = args.in[7]; F.wv_m = args.in[8];
    F.w_if = args.in[9]; F.b_if = args.in[10]; F.mnorm_g = args.in[11]; F.skip_m = args.in[12]; F.lam_q1 = args.in[13]; F.lam_k1 = args.in[14]; F.lam_q2 = args.in[15]; F.lam_k2 = args.in[16];
    F.dnorm_g = args.in[17]; F.mem_norm_g = args.in[18]; F.w_mem_kv = args.in[19]; F.w_out = args.in[20]; F.final_g = args.in[21];
    for (int u = F.tid; u < (LDS_BYTES - LDSCTL_OFF) / 4; u += NWAVES * 64) ((LAS unsigned*)(F.lds + LDSCTL_OFF))[u] = 0u;
    __syncthreads();
    XcdBarrier bar; bar.bar = (unsigned*)(F.ctl + CW_BAR); bar.x = 0; bar.st = nullptr;
    if (MK_N_LAUNCHES == 1) bar = xcd_barrier_post((unsigned*)(F.ctl + CW_BAR), F.MISC + 8);
    const int lo = args.ph_lo, hi = args.ph_hi;
#define IN(k) (lo <= (k) && (k) < hi)
#define SEAM(k) do { if (IN(k) && IN((k) + 1)) { PROBE_T0(tb_); xcd_barrier(bar); PROBE_ADD(F, 9, tb_); PROBE_ADD(F, 30, tph_); } } while (0)

    PROBE_T0(tk_); PROBE_T0(tph_);
    if (IN(0)) { p0_prologue(F); PROBE_ADD(F, 10, tph_);
#ifdef DUP_P0
        p0_prologue(F);
#endif
    }
    SEAM(0);
    if (IN(1)) {
#ifdef DUP_P1
        { pg8::Gemm g{(const bf16*)(F.ws + WS_H), (const bf16*)(F.ws + WS_WIN), M, INW, DM}; pg8::StaticOrder S; S.init(M, INW, F.G, (int)blockIdx.x);
          pg8::EpiBf16Q E{(bf16*)(F.ws + WS_P), M, 0.125f * 1.4426950408889634f, 0.08838834764831845f * 1.4426950408889634f};
          pg8::gemm_phase<pg8::EpiBf16Q, pg8::StaticOrder, PG8_ALIGN, PG8_SP2>(F.lds + RING_OFF, g, S, E); }
#endif
        { pg8::Gemm g{(const bf16*)(F.ws + WS_H), (const bf16*)(F.ws + WS_WIN), M, INW, DM}; pg8::StaticOrder S; S.init(M, INW, F.G, (int)blockIdx.x);
          pg8::EpiBf16Q E{(bf16*)(F.ws + WS_P), M, 0.125f * 1.4426950408889634f, 0.08838834764831845f * 1.4426950408889634f};
          pg8::gemm_phase<pg8::EpiBf16Q, pg8::StaticOrder, PG8_ALIGN, PG8_SP2>(F.lds + RING_OFF, g, S, E); }
        PROBE_ADD(F, 11, tph_);
        { pg8::Gemm g{(const bf16*)(F.ws + WS_MEMN), (const bf16*)(F.ws + WS_WMEM), MEMROWS, DM, DM}; pg8::StaticOrder S; S.init(MEMROWS, DM, F.G, (int)blockIdx.x);
          pg8::EpiBf16Q E{(bf16*)(F.ws + WS_MEMKV), MEMROWS, 1.f, 1.f};
          pg8::gemm_phase<pg8::EpiBf16Q, pg8::StaticOrder, PG8_ALIGN, PG8_SP2>(F.lds + RING_OFF, g, S, E); }
        PROBE_ADD(F, 12, tph_);
    }
    SEAM(1);
    if (IN(2)) {
#if EN_MLSTM && !defined(NO_M1)
        for (int u = F.vcu; u < BATCH * NCH; u += F.G) ml::m1_unit(F, u / NCH, u % NCH);
#ifdef DUP_M1
        for (int u = F.vcu; u < BATCH * NCH; u += F.G) ml::m1_unit(F, u / NCH, u % NCH);
#endif
#endif
        PROBE_ADD(F, 13, tph_);
#if EN_CROSS
        for (int v = F.vcu; v < BATCH * NH * 8; v += F.G) { const int bh = v >> 3; att::cross_pair(F, bh >> 2, bh & 3, (v & 7) * 2); }
#ifdef DUP_CROSS
        for (int u = F.vcu; u < BATCH * NH * (SEQ / 256); u += F.G) { const int bh = u / (SEQ / 256); att::cross_unit(F, bh >> 2, bh & 3, u % (SEQ / 256)); }
#endif
#endif
        PROBE_ADD(F, 14, tph_);
#if EN_DIFF
        { float s1 = 0.f, s2 = 0.f; for (int i = 0; i < 64; ++i) { s1 += F.lam_q1[i] * F.lam_k1[i]; s2 += F.lam_q2[i] * F.lam_k2[i]; }
          const float lam = expf(s1) - expf(s2) + 0.2f;
          for (int pid = F.vcu; pid < BATCH * NH * 16; pid += F.G) { const int bh = pid >> 4, j = pid & 15; att::diff_unit2(F, bh >> 2, bh & 3, 31 - j, lam); att::diff_unit2(F, bh >> 2, bh & 3, j, lam); }
#ifdef DUP_DIFF
          for (int pid = F.vcu; pid < BATCH * NH * 16; pid += F.G) { const int bh = pid >> 4, j = pid & 15; att::diff_unit(F, bh >> 2, bh & 3, 31 - j, lam); att::diff_unit(F, bh >> 2, bh & 3, j, lam); }
#endif
        }
#endif
        PROBE_ADD(F, 15, tph_);
    }
    SEAM(2);
    if (IN(3)) {
#if EN_MLSTM
        ml::m2_scan(F);
#ifdef DUP_M2
        ml::m2_scan(F);
#endif
#endif
        PROBE_ADD(F, 16, tph_);
    }
    SEAM(3);
    if (IN(4)) {
#if EN_MLSTM && !defined(NO_M3)
        for (int u = F.vcu; u < BATCH * NCH * NH; u += F.G) ml::m3_unit(F, u / (NCH * NH), (u / NH) % NCH, u % NH);
#ifdef DUP_M3
        for (int u = F.vcu; u < BATCH * NCH * NH; u += F.G) ml::m3_unit(F, u / (NCH * NH), (u / NH) % NCH, u % NH);
#endif
#endif
        PROBE_ADD(F, 17, tph_);
    }
    SEAM(4);
    if (IN(5)) {
#ifdef DUP_P5
        { pg8::Gemm g{(const bf16*)(F.ws + WS_Y), (const bf16*)(F.ws + WS_WOUT), M, DM, MIXW}; pg8::StaticOrder S; S.init(M, DM, F.G, (int)blockIdx.x);
          pg8::EpiResSS E{F.x, F.out, DM, (float*)(F.ws + WS_BB)};
          pg8::gemm_phase<pg8::EpiResSS, pg8::StaticOrder, PG8_ALIGN, PG8_SP2>(F.lds + RING_OFF, g, S, E); }
#endif
        pg8::Gemm g{(const bf16*)(F.ws + WS_Y), (const bf16*)(F.ws + WS_WOUT), M, DM, MIXW}; pg8::StaticOrder S; S.init(M, DM, F.G, (int)blockIdx.x);
        pg8::EpiResSS E{F.x, F.out, DM, (float*)(F.ws + WS_ROWSS)};
        pg8::gemm_phase<pg8::EpiResSS, pg8::StaticOrder, PG8_ALIGN, PG8_SP2>(F.lds + RING_OFF, g, S, E);
        PROBE_ADD(F, 18, tph_);
    }
    SEAM(5);
#ifdef DUP_P6
    if (IN(6)) { const int gw = F.vcu * NWAVES + F.wave, NGW = F.G * NWAVES;
        for (int m = gw; m < M; m += NGW) { GAS f32x4* o = (GAS f32x4*)(F.out + (size_t)m * DM) + F.lane;
#pragma unroll
            for (int j = 0; j < 4; ++j) o[64 * j] = o[64 * j] * 1.0f; }
        xcd_barrier(bar); }
#endif
    if (IN(6)) final_norm(F);
    PROBE_ADD(F, 19, tph_); PROBE_ADD(F, 8, tk_);
#ifdef PROBE_NUM
    if (IN(6) && blockIdx.x == 0 && threadIdx.x == 0) { const unsigned long long* pb = (const unsigned long long*)(F.ws + 512 * 1024); VM_WAIT();
        F.out[0] = 1000.f * (float)pb[PROBE_NUM] / (float)(PROBE_DEN >= 0 ? pb[PROBE_DEN] : 1000ull); }
#endif
#undef IN
#undef SEAM
}

extern "C" void kernel_launch(void* const* d_in, const int* in_sizes, int n_in, void* d_out, int out_size, void* d_ws, size_t ws_size, hipStream_t stream) {
    static int grid = 0;
    if (grid == 0) {
        if (n_in != 22 || in_sizes[0] != M * DM || out_size != M * DM || ws_size < WS_END) { fprintf(stderr, "kernel_launch: unexpected shapes (n_in %d in0 %d out %d ws %zu); nothing launched\n", n_in, n_in > 0 ? in_sizes[0] : -1, out_size, ws_size); grid = -1; return; }
        int dev = 0, cus = 0, per_cu = 0;
        if (hipGetDevice(&dev) != hipSuccess || hipDeviceGetAttribute(&cus, hipDeviceAttributeMultiprocessorCount, dev) != hipSuccess) { grid = -1; return; }
        if (hipFuncSetAttribute((const void*)hybrid_fwd, hipFuncAttributeMaxDynamicSharedMemorySize, LDS_BYTES) != hipSuccess) { fprintf(stderr, "kernel_launch: hipFuncSetAttribute failed\n"); grid = -1; return; }
        if (hipOccupancyMaxActiveBlocksPerMultiprocessor(&per_cu, (const void*)hybrid_fwd, NWAVES * 64, LDS_BYTES) != hipSuccess || per_cu < 1) { fprintf(stderr, "kernel_launch: occupancy query reports %d workgroups per CU\n", per_cu); (void)hipGetLastError(); grid = -1; return; }
        grid = cus;
    }
    if (grid < 0) return;
    (void)hipMemsetAsync((char*)d_ws + WS_CTL, 0, CTL_ZERO_BYTES, stream);
    Args a{};
    for (int i = 0; i < 22; ++i) a.in[i] = (const float*)d_in[i];
    a.out = (float*)d_out; a.ws = (unsigned char*)d_ws;
    if (MK_N_LAUNCHES == 1) { a.ph_lo = 0; a.ph_hi = N_PHASES; a.li = 0; hipLaunchKernelGGL(hybrid_fwd, dim3(grid), dim3(NWAVES * 64), LDS_BYTES, stream, a); }
    else for (int li = 0; li < N_PHASES; ++li) { a.ph_lo = li; a.ph_hi = li + 1; a.li = li; hipLaunchKernelGGL(hybrid_fwd, dim3(grid), dim3(NWAVES * 64), LDS_BYTES, stream, a); }
}
```
